# Optimizing an MI355X kernel written in HIP

```python
import jax, jax.numpy as jnp
from jax import lax
import numpy as np

D_MODEL = 2048
BATCH = 2
SEQ = 8192
DEPTH = 4

N_RET_LAYERS = DEPTH // 2
N_ATT_LAYERS = DEPTH - N_RET_LAYERS

RET_HEADS = 8
RET_QK_DIM = D_MODEL // RET_HEADS
RET_V_DIM = 2 * RET_QK_DIM
RET_CHUNK = 128
ROPE_BASE = 10000.0

DIL_CONFIGS = ((128, 1), (512, 4), (2048, 16))
N_GROUPS = len(DIL_CONFIGS)
ATT_HEAD_DIM = 128
ATT_HEADS = D_MODEL // ATT_HEAD_DIM
REL_BUCKETS = 32
REL_MAX_DIST = 2048
FFN_DIM = -(-8 * D_MODEL // (3 * 256)) * 256
NORM_EPS = 1e-6
NEG_INF = -1e30

kernel_name = "yoco_retention_dilated_attention_trunk"


def _rms(x, g):
    xf = x.astype(jnp.float32)
    y = xf * lax.rsqrt(jnp.mean(xf * xf, axis=-1, keepdims=True) + NORM_EPS)
    return (y * g.astype(jnp.float32)).astype(x.dtype)


def _swiglu(h, w_in, w_out):
    z = h @ w_in
    return (jax.nn.silu(z[..., :FFN_DIM]) * z[..., FFN_DIM:]) @ w_out


def _rope(t, cos, sin):
    half = t.shape[-1] // 2
    t1, t2 = t[..., :half], t[..., half:]
    return jnp.concatenate([t1 * cos - t2 * sin, t2 * cos + t1 * sin], axis=-1)


def _retention(q, k, v):
    B_, S_, H_, dk = q.shape
    dv = v.shape[-1]
    C = RET_CHUNK
    N = S_ // C
    log_g = np.log(1.0 - 2.0 ** (-5.0 - np.arange(H_))).astype(np.float32)
    idx = np.arange(C)
    diff = idx[:, None] - idx[None, :]
    dmask = np.where(diff[None] >= 0, np.exp(log_g[:, None, None] * np.maximum(diff, 0)[None]), 0.0)
    q_dec = np.exp(log_g[None, :] * (idx[:, None] + 1))
    k_dec = np.exp(log_g[None, :] * (C - 1 - idx)[:, None])
    c_dec = np.exp(log_g * C)
    dmask = jnp.asarray(dmask, dtype=q.dtype)
    q_dec = jnp.asarray(q_dec, dtype=q.dtype)
    k_dec = jnp.asarray(k_dec, dtype=q.dtype)
    c_dec = jnp.asarray(c_dec, dtype=q.dtype)

    def chunks(t):
        return jnp.moveaxis(t.reshape(B_, N, C, H_, t.shape[-1]), 1, 0)

    def step(R, inp):
        qc, kc, vc = inp
        s = jnp.einsum('bihd,bjhd->bhij', qc, kc) * dmask
        inner = jnp.einsum('bhij,bjhe->bihe', s, vc)
        cross = jnp.einsum('bihd,bhde->bihe', qc, R) * q_dec[None, :, :, None]
        R = R * c_dec[None, :, None, None] + jnp.einsum('bjhd,bjhe->bhde', kc * k_dec[None, :, :, None], vc)
        return R, inner + cross

    R0 = jnp.zeros((B_, H_, dk, dv), q.dtype)
    _, y = lax.scan(step, R0, (chunks(q), chunks(k), chunks(v)))
    return jnp.moveaxis(y, 0, 1).reshape(B_, S_, H_, dv)


def _retention_layer(h, w_in, w_out):
    B_, S_, _ = h.shape
    nq = RET_HEADS * RET_QK_DIM
    nv = RET_HEADS * RET_V_DIM
    z = h @ w_in
    q = z[..., :nq].reshape(B_, S_, RET_HEADS, RET_QK_DIM)
    k = z[..., nq:2 * nq].reshape(B_, S_, RET_HEADS, RET_QK_DIM) * (RET_QK_DIM ** -0.5)
    v = z[..., 2 * nq:2 * nq + nv].reshape(B_, S_, RET_HEADS, RET_V_DIM)
    g = z[..., 2 * nq + nv:]
    inv = (1.0 / ROPE_BASE ** np.linspace(0.0, 1.0, RET_QK_DIM // 2)).astype(np.float32)
    ang = jnp.arange(S_, dtype=jnp.float32)[:, None] * jnp.asarray(inv)[None, :]
    cos = jnp.cos(ang)[:, None, :].astype(h.dtype)
    sin = jnp.sin(ang)[:, None, :].astype(h.dtype)
    y = _retention(_rope(q, cos, sin), _rope(k, cos, sin), v)
    yf = y.astype(jnp.float32)
    y = (yf * lax.rsqrt(jnp.mean(yf * yf, axis=-1, keepdims=True) + NORM_EPS)).astype(h.dtype)
    y = y.reshape(B_, S_, nv) * jax.nn.silu(g)
    return y @ w_out


def _t5_bucket(dist):
    n = np.maximum(dist, 0)
    max_exact = REL_BUCKETS // 2
    large = max_exact + (np.log(np.maximum(n, 1) / max_exact) / np.log(REL_MAX_DIST / max_exact)
                         * (REL_BUCKETS - max_exact)).astype(np.int32)
    large = np.minimum(large, REL_BUCKETS - 1)
    return np.where(n < max_exact, n, large).astype(np.int32)


def _to_strided(t, d, blk):
    B_, S_, H_, E_ = t.shape
    L = S_ // d
    nb = -(-L // blk)
    t = t.reshape(B_, L, d, H_, E_).transpose(0, 2, 1, 3, 4)
    t = jnp.pad(t, ((0, 0), (0, 0), (0, nb * blk - L), (0, 0), (0, 0)))
    return t.reshape(B_, d, nb, blk, H_, E_)


def _from_strided(t, S_):
    B_, d, nb, blk = t.shape[:4]
    rest = t.shape[4:]
    t = t.reshape((B_, d, nb * blk) + rest)[:, :, :S_ // d]
    t = jnp.moveaxis(t, 1, 2)
    return t.reshape((B_, S_) + rest)


def _band(t):
    prev = jnp.pad(t[:, :, :-1], ((0, 0), (0, 0), (1, 0), (0, 0), (0, 0), (0, 0)))
    return jnp.concatenate([prev, t], axis=3)


def _shared_kv(x, g_kv, w_kv, rel_bias):
    B_, S_, _ = x.shape
    kv = (_rms(x, g_kv) @ w_kv).reshape(B_, S_, 2, N_GROUPS, ATT_HEADS, ATT_HEAD_DIM)
    shared, patterns = [], []
    for gi, (window, d) in enumerate(DIL_CONFIGS):
        blk = window // d
        nb = -(-(S_ // d) // blk)
        kb = _to_strided(kv[:, :, 0, gi], d, blk)
        vb = _to_strided(kv[:, :, 1, gi], d, blk)
        i = np.arange(blk)[:, None]
        c = np.arange(2 * blk)[None, :]
        delta = blk + i - c
        band = (delta >= 0) & (delta <= blk)
        bucket = _t5_bucket(np.maximum(delta, 0) * d)
        table_g = rel_bias[:, gi * ATT_HEADS:(gi + 1) * ATT_HEADS].astype(jnp.float32)
        bias = jnp.moveaxis(table_g[bucket], -1, 0)
        mask = band[None] & ((np.arange(nb)[:, None, None] > 0) | (c >= blk)[None])
        shared.append((kb, vb))
        patterns.append((bias, jnp.asarray(mask)))
    return shared, patterns


def _dilated_group(q, kb, vb, bias, mask, d):
    S_ = q.shape[1]
    blk = kb.shape[3]
    qb = _to_strided(q, d, blk)
    kband = _band(kb)
    vband = _band(vb)
    s = jnp.einsum('brnihe,brnjhe->brnhij', qb, kband).astype(jnp.float32) * (ATT_HEAD_DIM ** -0.5) + bias
    s = jnp.where(mask[None, None, :, None], s, NEG_INF)
    m = jnp.max(s, axis=-1, keepdims=True)
    p = jnp.exp(s - m)
    den = jnp.sum(p, axis=-1, keepdims=True)
    o = jnp.einsum('brnhij,brnjhe->brnihe', (p / den).astype(vb.dtype), vband)
    lse = jnp.moveaxis((m + jnp.log(den))[..., 0], 3, 4)
    return _from_strided(o, S_), _from_strided(lse, S_)


def _dilated_layer(h, w_q, w_out, shared, patterns):
    B_, S_, _ = h.shape
    q = (h @ w_q).reshape(B_, S_, N_GROUPS, ATT_HEADS, ATT_HEAD_DIM)
    outs, lses = [], []
    for gi, (window, d) in enumerate(DIL_CONFIGS):
        kb, vb = shared[gi]
        bias, mask = patterns[gi]
        o, lse = _dilated_group(q[:, :, gi], kb, vb, bias, mask, d)
        outs.append(o)
        lses.append(lse)
    wts = jax.nn.softmax(jnp.stack(lses, axis=0), axis=0)
    o = jnp.einsum('gbsh,gbshe->bshe', wts.astype(h.dtype), jnp.stack(outs, axis=0))
    return o.reshape(B_, S_, ATT_HEADS * ATT_HEAD_DIM) @ w_out


def setup_inputs(seed: int = 0) -> dict:
    key = jax.random.key(seed)
    ks = jax.random.split(key, 13)
    res = (2.0 * DEPTH) ** -0.5
    nq = RET_HEADS * RET_QK_DIM
    nv = RET_HEADS * RET_V_DIM
    natt = N_GROUPS * ATT_HEADS * ATT_HEAD_DIM

    def nrm(k, shape, fan_in, scale=1.0):
        return jax.random.normal(k, shape, jnp.float32) * (scale * fan_in ** -0.5)

    def gain(k, shape):
        return 1.0 + 0.05 * jax.random.normal(k, shape, jnp.float32)

    return {
        "x": jax.random.normal(ks[0], (BATCH, SEQ, D_MODEL), jnp.float32),
        "g_mix": gain(ks[1], (DEPTH, D_MODEL)),
        "g_ffn": gain(ks[2], (DEPTH, D_MODEL)),
        "w_ret_in": nrm(ks[3], (N_RET_LAYERS, D_MODEL, 2 * nq + 2 * nv), D_MODEL),
        "w_ret_out": nrm(ks[4], (N_RET_LAYERS, nv, D_MODEL), nv, res),
        "g_kv": gain(ks[5], (D_MODEL,)),
        "w_kv": nrm(ks[6], (D_MODEL, 2 * natt), D_MODEL),
        "w_att_q": nrm(ks[7], (N_ATT_LAYERS, D_MODEL, natt), D_MODEL),
        "w_att_out": nrm(ks[8], (N_ATT_LAYERS, ATT_HEADS * ATT_HEAD_DIM, D_MODEL), ATT_HEADS * ATT_HEAD_DIM, res),
        "rel_bias": 0.1 * jax.random.normal(ks[9], (REL_BUCKETS, N_GROUPS * ATT_HEADS), jnp.float32),
        "w_ffn_in": nrm(ks[10], (DEPTH, D_MODEL, 2 * FFN_DIM), D_MODEL),
        "w_ffn_out": nrm(ks[11], (DEPTH, FFN_DIM, D_MODEL), FFN_DIM, res),
        "g_final": gain(ks[12], (D_MODEL,)),
    }


def reference(x, g_mix, g_ffn, w_ret_in, w_ret_out, g_kv, w_kv, w_att_q, w_att_out, rel_bias, w_ffn_in, w_ffn_out, g_final):
    shared, patterns = None, None
    for l in range(DEPTH):
        if l < N_RET_LAYERS:
            x = x + _retention_layer(_rms(x, g_mix[l]), w_ret_in[l], w_ret_out[l])
        else:
            if l == N_RET_LAYERS:
                shared, patterns = _shared_kv(x, g_kv, w_kv, rel_bias)
            j = l - N_RET_LAYERS
            x = x + _dilated_layer(_rms(x, g_mix[l]), w_att_q[j], w_att_out[j], shared, patterns)
        x = x + _swiglu(_rms(x, g_ffn[l]), w_ffn_in[l], w_ffn_out[l])
    return _rms(x, g_final)
```

```cpp
#include <hip/hip_runtime.h>
#include <cstdio>
#include <cstdint>
#include <cmath>

#ifndef MK_N_LAUNCHES
#define MK_N_LAUNCHES 1
#endif


#ifndef REP_P0
#define REP_P0 1
#endif
#ifndef REP_RS
#define REP_RS 1
#endif
#ifndef REP_RO
#define REP_RO 1
#endif
#ifndef REP_AT
#define REP_AT 1
#endif
#ifndef REP_MG
#define REP_MG 1
#endif
#ifndef EN_ALL
#define EN_ALL 1
#endif
#ifndef EN_P0
#define EN_P0 EN_ALL
#endif
#ifndef EN_G1
#define EN_G1 EN_ALL
#endif
#ifndef EN_G2
#define EN_G2 EN_ALL
#endif
#ifndef EN_G3
#define EN_G3 EN_ALL
#endif
#ifndef EN_G4
#define EN_G4 EN_ALL
#endif
#ifndef EN_G5
#define EN_G5 EN_ALL
#endif
#ifndef EN_RS
#define EN_RS EN_ALL
#endif
#ifndef EN_RO
#define EN_RO EN_ALL
#endif
#ifndef EN_AT
#define EN_AT EN_ALL
#endif
#define LAS __attribute__((address_space(3)))
#define GAS __attribute__((address_space(1)))
typedef _Float16 f16;
typedef _Float16 f16x8 __attribute__((ext_vector_type(8)));
typedef _Float16 f16x4 __attribute__((ext_vector_type(4)));
typedef _Float16 f16x2 __attribute__((ext_vector_type(2)));
typedef float f32x4 __attribute__((ext_vector_type(4)));
typedef float f32x2 __attribute__((ext_vector_type(2)));
typedef unsigned u32x4 __attribute__((ext_vector_type(4)));
typedef unsigned u32x2 __attribute__((ext_vector_type(2)));
typedef short v4i16 __attribute__((ext_vector_type(4)));

constexpr int BATCH = 2, SEQ = 8192, DM = 2048, M = BATCH * SEQ;
constexpr int RH = 8, RDK = 256, RDV = 512, RC = 128, NCH = SEQ / RC;
constexpr int NRETIN = 12288;
constexpr int AH = 16, AE = 128, NG = 3, NATT = 6144, NKV = 12288;
constexpr int FF = 5632;
constexpr float NORM_EPS = 1e-6f;

__device__ __forceinline__ int opaque_tid() { int t; asm volatile("v_mov_b32 %0, %1" : "=v"(t) : "v"(threadIdx.x)); return t; }
__device__ __forceinline__ unsigned pk2h(float a, float b) { f16x2 h = {(f16)a, (f16)b}; return __builtin_bit_cast(unsigned, h); }
typedef __bf16 bf16x2_t __attribute__((ext_vector_type(2)));
typedef __bf16 bf16x8_t __attribute__((ext_vector_type(8)));
__device__ __forceinline__ unsigned pk2bf(float a, float b) { f32x2 v = {a, b}; bf16x2_t h = __builtin_convertvector(v, bf16x2_t); return __builtin_bit_cast(unsigned, h); }
__device__ __forceinline__ float silu_f(float z) { return z * __builtin_amdgcn_rcpf(1.0f + __expf(-z)); }

namespace pg8 {
constexpr int BM = 256, BK = 64, HALF = 128, HTB = HALF * BK * 2, STAGE_BYTES = 8 * HTB, NXCD = 8, WGM = 4, WGM_WIDE = 8;
__host__ __device__ __forceinline__ int lds_byte(int r, int c) { const int st = (r >> 4) * 2 + (c >> 5), rr = r & 15, cc = c & 31, ob = rr * 64 + cc * 2; return st * 1024 + (ob ^ (((ob >> 9) & 1) << 5)); }
__host__ __device__ __forceinline__ void stage_rc(int b, int& R, int& C) { const int st = b / 1024, sb = b % 1024, swz = sb ^ (((sb >> 9) & 1) << 5); R = (st >> 1) * 16 + swz / 64; C = (st & 1) * 32 + (swz % 64) / 2; }
__host__ __device__ __forceinline__ int perm32(int rho) { const int n = rho >> 4, i = rho & 15; return 8 * (i >> 2) + 4 * n + (i & 3); }

struct Unit { int pm, pn; };
struct Gemm { const f16* A; const f16* Bt; int M, N, K; };

struct StaticOrder {
    int nM, nN, nwg, G, c, wgm;
    __host__ __device__ void init(int M_, int N_, int G_, int c_) { nM = M_ / BM; nN = N_ / BM; nwg = nM * nN; G = G_; c = c_; wgm = (nN <= 8) ? 4 : WGM_WIDE; }
    __host__ __device__ bool next(int i, Unit& u) const {
        const long L = (long)i * G + c; if (L >= nwg) return false;
        int wgid = (int)L; { const int q = nwg / NXCD, r = nwg % NXCD, xcd = wgid % NXCD, off = wgid / NXCD; wgid = (xcd < r ? xcd * (q + 1) : r * (q + 1) + (xcd - r) * q) + off; }
        const int nig = wgm * nN, gid = wgid / nig, fm = gid * wgm, gsz = (nM - fm) < wgm ? (nM - fm) : wgm;
        u.pm = fm + ((wgid % nig) % gsz); u.pn = (wgid % nig) / gsz; return true;
    }
    __device__ __forceinline__ void a_ready(const Unit&) const {}
    __device__ __forceinline__ void done(const Unit&) const {}
};

template <class Epi, class Sched, bool ALIGN_EPI = true, bool BF16 = false>
__device__ __forceinline__ void gemm_phase(LAS unsigned char* lds, const Gemm g, const Sched& S, const Epi& E) {
    const int tid = opaque_tid(), wid = __builtin_amdgcn_readfirstlane(tid >> 6), lane = tid & 63, wr = wid >> 2, wc = wid & 3, fr = lane & 15, fq = lane >> 4;
    const int K = g.K, nt = K / BK;
    unsigned voffA[2], voffB[2];
#pragma unroll
    for (int i = 0; i < 2; ++i) { int R, C; stage_rc(tid * 16 + i * 8192, R, C); const int Rb = (R & ~31) + perm32(R & 31);
        voffA[i] = (unsigned)(R * K + C) * 2u; voffB[i] = (unsigned)(Rb * K + C) * 2u; }
    const size_t kstep = (size_t)(BK * 2);
    const size_t hstep = (size_t)HALF * K * 2;
    const size_t tstep = 2 * hstep;
    const unsigned ldsw = (unsigned)wid * 1024u;
    const int aoff = lds_byte(wr * 64 + fr, fq * 8), boff = lds_byte(wc * 32 + fr, fq * 8);
#define PG8_SA(b, h) (((b) * 2 + (h)) * HTB)
#define PG8_SB(b, h) ((4 + (b) * 2 + (h)) * HTB)
#define PG8_STAGE(bufoff, gbase, voff) do { _Pragma("unroll") for (int _i = 0; _i < 2; ++_i) \
        __builtin_amdgcn_global_load_lds((const unsigned*)((const char*)(gbase) + (voff)[_i]), (LAS unsigned*)(lds + (bufoff) + ldsw + _i * 8192), 16, 0, 0); } while (0)
#define PG8_LDA(dst, b, h) do { _Pragma("unroll") for (int m = 0; m < 4; ++m) _Pragma("unroll") for (int k = 0; k < 2; ++k) dst[m][k] = *(const LAS f16x8*)(lds + PG8_SA(b, h) + aoff + m * 2048 + k * 1024); } while (0)
#define PG8_LDB(dst, b, h) do { _Pragma("unroll") for (int n = 0; n < 2; ++n) _Pragma("unroll") for (int k = 0; k < 2; ++k) dst[n][k] = *(const LAS f16x8*)(lds + PG8_SB(b, h) + boff + n * 2048 + k * 1024); } while (0)
#define PG8_MMA(ai, bj, At, Bt) do { __builtin_amdgcn_s_setprio(1); _Pragma("unroll") for (int m = 0; m < 4; ++m) _Pragma("unroll") for (int n = 0; n < 2; ++n) _Pragma("unroll") for (int k = 0; k < 2; ++k) \
        acc[ai][bj][m][n] = BF16 ? __builtin_amdgcn_mfma_f32_16x16x32_bf16(__builtin_bit_cast(bf16x8_t, Bt[n][k]), __builtin_bit_cast(bf16x8_t, At[m][k]), acc[ai][bj][m][n], 0, 0, 0) \
                                 : __builtin_amdgcn_mfma_f32_16x16x32_f16(Bt[n][k], At[m][k], acc[ai][bj][m][n], 0, 0, 0); __builtin_amdgcn_s_setprio(0); } while (0)
#define PG8_WAIT_V(n) asm volatile("s_waitcnt vmcnt(" #n ")" ::: "memory")
#define PG8_WAIT_L(n) asm volatile("s_waitcnt lgkmcnt(" #n ")" ::: "memory")
#define PG8_BAR __builtin_amdgcn_s_barrier()
#define PG8_SCHED __builtin_amdgcn_sched_barrier(0)
    Unit cur, nxt; int ui = 0;
    if (!S.next(0, cur)) return;
    f32x4 acc[2][2][4][2];
#pragma unroll
    for (int a = 0; a < 2; ++a)
#pragma unroll
        for (int b = 0; b < 2; ++b)
#pragma unroll
            for (int m = 0; m < 4; ++m)
#pragma unroll
                for (int n = 0; n < 2; ++n) acc[a][b][m][n] = (f32x4){0.f, 0.f, 0.f, 0.f};
    f16x8 At[4][2], B0[2][2], B1[2][2];
    float pref[8];
#pragma unroll
    for (int i = 0; i < 8; ++i) pref[i] = 0.f;
    const char* cA = (const char*)g.A + (size_t)cur.pm * tstep; const char* cB = (const char*)g.Bt + (size_t)cur.pn * tstep;
    S.a_ready(cur);
    PG8_STAGE(PG8_SB(0, 0), cB, voffB); PG8_STAGE(PG8_SB(0, 1), cB + hstep, voffB); PG8_STAGE(PG8_SA(0, 0), cA, voffA); PG8_STAGE(PG8_SA(0, 1), cA + hstep, voffA);
    if (wr == 1) PG8_BAR;
    PG8_WAIT_V(2); PG8_BAR;
    PG8_STAGE(PG8_SB(1, 0), cB + kstep, voffB); PG8_STAGE(PG8_SA(1, 0), cA + kstep, voffA); PG8_STAGE(PG8_SB(1, 1), cB + hstep + kstep, voffB);
    PG8_WAIT_V(6); PG8_BAR;
    for (;;) {
        const bool has_next = S.next(ui + 1, nxt);
        const char* nA = has_next ? (const char*)g.A + (size_t)nxt.pm * tstep : cA; const char* nB = has_next ? (const char*)g.Bt + (size_t)nxt.pn * tstep : cB;
        for (int t = 0; t < nt; t += 2) {
            const bool last = (t == nt - 2);
            const char* a1 = cA + (size_t)(t + 1) * kstep;
            const char* a2 = last ? nA : cA + (size_t)(t + 2) * kstep; const char* b2 = last ? nB : cB + (size_t)(t + 2) * kstep;
            const char* a3 = a2 + kstep; const char* b3 = b2 + kstep;
            if (last && has_next) S.a_ready(nxt);
            if (last) E.pre(cur, wr, fr, pref);
            PG8_LDB(B0, 0, 0); PG8_LDB(B1, 0, 1); PG8_SCHED; PG8_LDA(At, 0, 0); PG8_STAGE(PG8_SA(1, 1), a1 + hstep, voffA);
            PG8_WAIT_V(8); PG8_WAIT_L(0); PG8_BAR; PG8_MMA(0, 0, At, B0); PG8_MMA(0, 1, At, B1); PG8_BAR; PG8_SCHED;
            PG8_LDA(At, 0, 1); PG8_STAGE(PG8_SB(0, 0), b2, voffB); PG8_STAGE(PG8_SB(0, 1), b2 + hstep, voffB); PG8_STAGE(PG8_SA(0, 0), a2, voffA);
            PG8_WAIT_V(8); PG8_WAIT_L(0); PG8_BAR; PG8_MMA(1, 0, At, B0); PG8_MMA(1, 1, At, B1); PG8_BAR; PG8_SCHED;
            PG8_LDB(B0, 1, 0); PG8_LDB(B1, 1, 1); PG8_SCHED; PG8_LDA(At, 1, 0); PG8_STAGE(PG8_SA(0, 1), a2 + hstep, voffA);
            PG8_WAIT_V(8); PG8_WAIT_L(0); PG8_BAR; PG8_MMA(0, 0, At, B0); PG8_MMA(0, 1, At, B1); PG8_BAR; PG8_SCHED;
            PG8_LDA(At, 1, 1); PG8_STAGE(PG8_SB(1, 0), b3, voffB); PG8_STAGE(PG8_SB(1, 1), b3 + hstep, voffB); PG8_STAGE(PG8_SA(1, 0), a3, voffA);
            PG8_WAIT_V(8); PG8_WAIT_L(0); PG8_BAR; PG8_MMA(1, 0, At, B0); PG8_MMA(1, 1, At, B1); PG8_BAR; PG8_SCHED;
        }
        if constexpr (ALIGN_EPI) { if (wr == 0) PG8_BAR; }
        E(acc, cur, wr, wc, fr, fq, pref); S.done(cur);
        if (!has_next) break;
#pragma unroll
        for (int a = 0; a < 2; ++a)
#pragma unroll
            for (int b = 0; b < 2; ++b)
#pragma unroll
                for (int m = 0; m < 4; ++m)
#pragma unroll
                    for (int n = 0; n < 2; ++n) acc[a][b][m][n] = (f32x4){0.f, 0.f, 0.f, 0.f};
        cur = nxt; cA = nA; cB = nB; ++ui;
        if constexpr (ALIGN_EPI) { if (wr == 1) PG8_BAR; }
    }
    PG8_WAIT_V(0);
    if constexpr (!ALIGN_EPI) { if (wr == 0) PG8_BAR; }
    PG8_BAR;
#undef PG8_SA
#undef PG8_SB
#undef PG8_STAGE
#undef PG8_LDA
#undef PG8_LDB
#undef PG8_MMA
#undef PG8_WAIT_V
#undef PG8_WAIT_L
#undef PG8_BAR
#undef PG8_SCHED
}

__device__ __forceinline__ float rstd_v(float sumsq) { return __builtin_amdgcn_rsqf(sumsq * (1.0f / DM) + NORM_EPS); }
__device__ __forceinline__ u32x4 pk8(const f32x4 a, const f32x4 b) { u32x4 w; w.x = pk2h(a[0], a[1]); w.y = pk2h(a[2], a[3]); w.z = pk2h(b[0], b[1]); w.w = pk2h(b[2], b[3]); return w; }

struct EpiRetIn {
    f16* Z; const float* ss; const float* cosT; const float* sinT;
    __device__ __forceinline__ void pre(const Unit& u, int wr, int fr, float (&pref)[8]) const {
        const int row0 = u.pm * BM + wr * 64 + fr;
#pragma unroll
        for (int ai = 0; ai < 2; ++ai)
#pragma unroll
            for (int m = 0; m < 4; ++m) pref[ai * 4 + m] = ss[row0 + ai * HALF + m * 16]; }
    __device__ __forceinline__ void operator()(const f32x4 (&acc)[2][2][4][2], const Unit& u, int wr, int wc, int fr, int fq, const float (&pref)[8]) const {
        const int row0 = u.pm * BM + wr * 64 + fr, colt = u.pn * BM, cl = wc * 32 + 8 * fq;
        if (u.pn < 16) {
            const float ksc = (u.pn >= 8) ? 0.0625f : 1.0f;
#pragma unroll
            for (int ai = 0; ai < 2; ++ai)
#pragma unroll
                for (int m = 0; m < 4; ++m) { const int row = row0 + ai * HALF + m * 16; const float rs = rstd_v(pref[ai * 4 + m]) * ksc; const int pos = row & (SEQ - 1);
                    const f32x4 c0 = *(const f32x4*)(cosT + (size_t)pos * 128 + cl), c1 = *(const f32x4*)(cosT + (size_t)pos * 128 + cl + 4);
                    const f32x4 s0 = *(const f32x4*)(sinT + (size_t)pos * 128 + cl), s1 = *(const f32x4*)(sinT + (size_t)pos * 128 + cl + 4);
                    const f32x4 a0 = acc[ai][0][m][0] * rs, a1 = acc[ai][0][m][1] * rs, b0 = acc[ai][1][m][0] * rs, b1 = acc[ai][1][m][1] * rs;
                    const f32x4 o10 = a0 * c0 - b0 * s0, o11 = a1 * c1 - b1 * s1, o20 = b0 * c0 + a0 * s0, o21 = b1 * c1 + a1 * s1;
                    f16* rp = Z + (size_t)row * NRETIN + colt + cl;
                    *(u32x4*)(rp) = pk8(o10, o11); *(u32x4*)(rp + HALF) = pk8(o20, o21); }
        } else {
            const bool gate = (u.pn >= 32);
#pragma unroll
            for (int ai = 0; ai < 2; ++ai)
#pragma unroll
                for (int m = 0; m < 4; ++m) { const int row = row0 + ai * HALF + m * 16; const float rs = rstd_v(pref[ai * 4 + m]);
                    f16* rp = Z + (size_t)row * NRETIN + colt + cl;
#pragma unroll
                    for (int bj = 0; bj < 2; ++bj) { f32x4 v0 = acc[ai][bj][m][0] * rs, v1 = acc[ai][bj][m][1] * rs;
                        if (gate) {
#pragma unroll
                            for (int j = 0; j < 4; ++j) { v0[j] = silu_f(v0[j]); v1[j] = silu_f(v1[j]); } }
                        *(u32x4*)(rp + bj * HALF) = pk8(v0, v1); } }
        }
    }
};
struct EpiPlain {
    f16* O0; int ld0; f16* O1; int ld1; int split; float sc1; const float* ss;
    __device__ __forceinline__ void pre(const Unit& u, int wr, int fr, float (&pref)[8]) const {
        const int row0 = u.pm * BM + wr * 64 + fr;
#pragma unroll
        for (int ai = 0; ai < 2; ++ai)
#pragma unroll
            for (int m = 0; m < 4; ++m) pref[ai * 4 + m] = ss[row0 + ai * HALF + m * 16]; }
    __device__ __forceinline__ void operator()(const f32x4 (&acc)[2][2][4][2], const Unit& u, int wr, int wc, int fr, int fq, const float (&pref)[8]) const {
        const int row0 = u.pm * BM + wr * 64 + fr, cl = wc * 32 + 8 * fq;
        const bool second = u.pn >= split; f16* O = second ? O1 : O0; const int ld = second ? ld1 : ld0; const int colt = (second ? u.pn - split : u.pn) * BM; const float sc = second ? sc1 : 1.0f;
#pragma unroll
        for (int ai = 0; ai < 2; ++ai)
#pragma unroll
            for (int m = 0; m < 4; ++m) { const int row = row0 + ai * HALF + m * 16; const float rs = rstd_v(pref[ai * 4 + m]) * sc;
                f16* rp = O + (size_t)row * ld + colt + cl;
#pragma unroll
                for (int bj = 0; bj < 2; ++bj) *(u32x4*)(rp + bj * HALF) = pk8(acc[ai][bj][m][0] * rs, acc[ai][bj][m][1] * rs); }
    }
};
struct EpiSwiglu {
    f16* Hd; const float* ss;
    __device__ __forceinline__ void pre(const Unit& u, int wr, int fr, float (&pref)[8]) const {
        const int row0 = u.pm * BM + wr * 64 + fr;
#pragma unroll
        for (int ai = 0; ai < 2; ++ai)
#pragma unroll
            for (int m = 0; m < 4; ++m) pref[ai * 4 + m] = ss[row0 + ai * HALF + m * 16]; }
    __device__ __forceinline__ void operator()(const f32x4 (&acc)[2][2][4][2], const Unit& u, int wr, int wc, int fr, int fq, const float (&pref)[8]) const {
        const int row0 = u.pm * BM + wr * 64 + fr, cl = wc * 32 + 8 * fq;
#pragma unroll
        for (int ai = 0; ai < 2; ++ai)
#pragma unroll
            for (int m = 0; m < 4; ++m) { const int row = row0 + ai * HALF + m * 16; const float rs = rstd_v(pref[ai * 4 + m]);
                f32x4 h0, h1;
#pragma unroll
                for (int j = 0; j < 4; ++j) { h0[j] = silu_f(acc[ai][0][m][0][j] * rs) * (acc[ai][1][m][0][j] * rs); h1[j] = silu_f(acc[ai][0][m][1][j] * rs) * (acc[ai][1][m][1][j] * rs); }
                u32x4 hw; hw.x = pk2bf(h0[0], h0[1]); hw.y = pk2bf(h0[2], h0[3]); hw.z = pk2bf(h1[0], h1[1]); hw.w = pk2bf(h1[2], h1[3]);
                *(u32x4*)(Hd + (size_t)row * FF + u.pn * HALF + cl) = hw; }
    }
};
struct EpiRes {
    f16* x16; float* ssn; f16* xb;
    __device__ __forceinline__ void pre(const Unit&, int, int, float (&)[8]) const {}
    __device__ __forceinline__ void operator()(const f32x4 (&acc)[2][2][4][2], const Unit& u, int wr, int wc, int fr, int fq, const float (&pref)[8]) const {
        const int row0 = u.pm * BM + wr * 64 + fr, col0 = u.pn * BM + wc * 32 + 8 * fq;
        f16x8 old[2][4][2];
        float sqv[2][4];
#pragma unroll
        for (int ai = 0; ai < 2; ++ai)
#pragma unroll
            for (int m = 0; m < 4; ++m) { const size_t off = (size_t)(row0 + ai * HALF + m * 16) * DM + col0;
                old[ai][m][0] = *(const f16x8*)(x16 + off); old[ai][m][1] = *(const f16x8*)(x16 + off + HALF); }
#pragma unroll
        for (int ai = 0; ai < 2; ++ai)
#pragma unroll
            for (int m = 0; m < 4; ++m) { const int row = row0 + ai * HALF + m * 16; const size_t off = (size_t)row * DM + col0; float sq = 0.f;
#pragma unroll
                for (int bj = 0; bj < 2; ++bj) { const f16x8 ov = old[ai][m][bj];
                    const f32x4 x0 = (f32x4){(float)ov[0], (float)ov[1], (float)ov[2], (float)ov[3]} + acc[ai][bj][m][0], x1 = (f32x4){(float)ov[4], (float)ov[5], (float)ov[6], (float)ov[7]} + acc[ai][bj][m][1];
                    *(u32x4*)(x16 + off + bj * HALF) = pk8(x0, x1);
                    if (xb) { u32x4 hw; hw.x = pk2bf(x0[0], x0[1]); hw.y = pk2bf(x0[2], x0[3]); hw.z = pk2bf(x1[0], x1[1]); hw.w = pk2bf(x1[2], x1[3]); *(u32x4*)(xb + off + bj * HALF) = hw; }
                    sq += (x0[0] * x0[0] + x0[1] * x0[1]) + (x0[2] * x0[2] + x0[3] * x0[3]) + (x1[0] * x1[0] + x1[1] * x1[1]) + (x1[2] * x1[2] + x1[3] * x1[3]); }
                sq += __shfl_xor(sq, 16); sq += __shfl_xor(sq, 32);
                sqv[ai][m] = sq; }
#pragma unroll
        for (int ai = 0; ai < 2; ++ai) { const float v = (fq == 0) ? sqv[ai][0] : (fq == 1) ? sqv[ai][1] : (fq == 2) ? sqv[ai][2] : sqv[ai][3];
            __hip_atomic_fetch_add(ssn + (row0 + ai * HALF + 16 * fq), v, __ATOMIC_RELAXED, __HIP_MEMORY_SCOPE_AGENT); }
    }
};
}

constexpr size_t MiB = 1u << 20;
constexpr size_t WS_CTL = 0, CTL_ZERO_BYTES = 2 * MiB;
constexpr int CW_TMO = 0, CW_BAR = 4096;
constexpr size_t CTL_SS = 65536;
constexpr size_t WS_COS = 2 * MiB, WS_SIN = 6 * MiB, WS_BIAS = 10 * MiB, WS_LSE = 11 * MiB;
constexpr size_t WS_W_RETIN = 16 * MiB, WS_W_RETOUT = 112 * MiB, WS_W_KV = 144 * MiB, WS_W_Q = 192 * MiB, WS_W_ATTOUT = 240 * MiB, WS_W_FFNIN = 256 * MiB, WS_W_FFNOUT = 432 * MiB;
constexpr size_t WS_X16 = 520 * MiB;
constexpr size_t WS_Z16 = 584 * MiB, WS_STATE = 968 * MiB, WS_Y = 1224 * MiB, WS_HID_RET = 584 * MiB;
constexpr size_t WS_KV = 584 * MiB, WS_QATT = 968 * MiB, WS_OG = 1160 * MiB, WS_O16 = 1160 * MiB, WS_HID_ATT = 1160 * MiB;
constexpr size_t WS_XB16 = 1032 * MiB;
constexpr size_t WS_END = 1352 * MiB;
constexpr int BIAS_PITCH = 132;

constexpr int RING_BYTES = 131072, LDS_BYTES = 147456, LDSCTL_OFF = LDS_BYTES - 512, MISC_OFF = LDSCTL_OFF + 320, NWAVES = 8;

#define RLX_AGENT __ATOMIC_RELAXED, __HIP_MEMORY_SCOPE_AGENT
#define LDS_WAIT() asm volatile("s_waitcnt lgkmcnt(0)" ::: "memory")
#define VM_WAIT() asm volatile("s_waitcnt vmcnt(0)" ::: "memory")

#define XB_TMO      128
#define XB_XCNT(j)  (256  + 64 * (j))
#define XB_XSUB(j)  (1280 + 64 * (j))
#define XB_XGEN(j)  (2304 + 64 * (j))
#define XB_TOP      3328
#define XB_TOPGEN   3392
#define XCD_BAR_WORDS 3456
#define XB_SPIN_CAP (1u << 18)
__device__ __forceinline__ unsigned xb_ld(unsigned* p)              { return __hip_atomic_load(p, __ATOMIC_RELAXED, __HIP_MEMORY_SCOPE_AGENT); }
__device__ __forceinline__ unsigned xb_add(unsigned* p, unsigned v) { return __hip_atomic_fetch_add(p, v, __ATOMIC_RELAXED, __HIP_MEMORY_SCOPE_AGENT); }
__device__ __forceinline__ unsigned xb_xcc_id() { return (unsigned)__builtin_amdgcn_s_getreg((3 << 11) | 20) & 0xFu; }
#define XB_SPIN(cond, bar) do { unsigned _sp = 0; while (cond) { __builtin_amdgcn_s_sleep(1); \
    if ((++_sp & 255u) == 0u) { if (xb_ld(&(bar)[XB_TMO])) break; if (_sp > XB_SPIN_CAP) { atomicAdd(&(bar)[XB_TMO], 1u); break; } } } } while (0)
struct XcdBarrier { unsigned* bar; unsigned x; volatile LAS unsigned* st; };
__device__ __forceinline__ XcdBarrier xcd_barrier_post(unsigned* bar, volatile LAS unsigned* st) {
    XcdBarrier b; b.bar = bar; b.x = xb_xcc_id(); b.st = st;
    if (threadIdx.x == 0) (void)xb_add(&bar[XB_XCNT(b.x)], 1u);
    return b;
}
__device__ __forceinline__ void xcd_barrier_complete(unsigned* bar, unsigned x, unsigned& nloc, unsigned& nx) {
    const unsigned G = gridDim.x * gridDim.y * gridDim.z;
    unsigned sum, cnt, mine, sp = 0u;
    for (;;) {
        sum = 0u; cnt = 0u; mine = 0u;
#pragma unroll
        for (unsigned j = 0; j < 16; ++j) { const unsigned c = xb_ld(&bar[XB_XCNT(j)]); sum += c; cnt += (c > 0u) ? 1u : 0u; mine = (j == x) ? c : mine; }
        if (sum == G) break;
        __builtin_amdgcn_s_sleep(1);
        if ((++sp & 255u) == 0u) { if (xb_ld(&bar[XB_TMO])) break; if (sp > XB_SPIN_CAP) { atomicAdd(&bar[XB_TMO], 1u); break; } }
    }
    nloc = mine > 0u ? mine : 1u; nx = cnt > 0u ? cnt : 1u;
}
__device__ __forceinline__ void xcd_barrier(const XcdBarrier& b) {
    asm volatile("s_waitcnt vmcnt(0)" ::: "memory");
    __syncthreads();
    if (threadIdx.x == 0) {
        unsigned* bar = b.bar;
        __builtin_amdgcn_s_waitcnt(0);
        unsigned nloc = b.st[0], nx = b.st[1];
        if (nloc == 0u) { xcd_barrier_complete(bar, b.x, nloc, nx); b.st[0] = nloc; b.st[1] = nx; }
        const unsigned old = xb_add(&bar[XB_XSUB(b.x)], 1u);
        const unsigned gen = old / nloc;
        if (old + 1u == (gen + 1u) * nloc) {
            __builtin_amdgcn_fence(__ATOMIC_RELEASE, "agent");
            asm volatile("s_waitcnt vmcnt(0)" ::: "memory");
            const unsigned og = xb_add(&bar[XB_TOP], 1u);
            const unsigned tg = og / nx;
            if (og + 1u == (tg + 1u) * nx) xb_add(&bar[XB_TOPGEN], 1u);
            else XB_SPIN(xb_ld(&bar[XB_TOPGEN]) == tg, bar);
            __builtin_amdgcn_fence(__ATOMIC_ACQUIRE, "agent");
            xb_add(&bar[XB_XGEN(b.x)], 1u);
            asm volatile("s_waitcnt vmcnt(0)" ::: "memory");
        } else {
            XB_SPIN(xb_ld(&bar[XB_XGEN(b.x)]) == gen, bar);
            __builtin_amdgcn_fence(__ATOMIC_ACQUIRE, "agent");
            asm volatile("s_waitcnt vmcnt(0)" ::: "memory");
        }
    }
    __syncthreads();
}

__device__ __forceinline__ float wave_sum(float v) {
#pragma unroll
    for (int o = 1; o < 64; o <<= 1) v += __shfl_xor(v, o);
    return v;
}
constexpr int TP = 272, TILE_B = 128 * TP;
__device__ __forceinline__ void tile_load(u32x4 (&r)[4], const f16* src, unsigned stride_bytes, int tid) {
    const unsigned vo = (unsigned)(tid >> 4) * stride_bytes + (unsigned)(tid & 15) * 16u;
#pragma unroll
    for (int i = 0; i < 4; ++i) r[i] = *(const u32x4*)(((const char*)src + (size_t)i * 32u * stride_bytes) + vo);
}
template <int P = TP>
__device__ __forceinline__ void tile_store(LAS unsigned char* buf, const u32x4 (&r)[4], int tid) {
    LAS unsigned char* p = buf + (tid >> 4) * P + (tid & 15) * 16;
#pragma unroll
    for (int i = 0; i < 4; ++i) *(LAS u32x4*)(p + i * 32 * P) = r[i];
}
__device__ __forceinline__ f16x8 frag_row(const LAS unsigned char* buf, int rb, int ks, int li, int g) { return *(const LAS f16x8*)(buf + (li * TP + g * 16) + (rb * 16 * TP + ks * 64)); }
template <bool PERMK, int P = TP>
__device__ __forceinline__ f16x8 frag_tr(const LAS unsigned char* buf, int kbase, int cb, int li, int g) {
    const int q = li >> 2, p = li & 3;
    const LAS unsigned char* a0 = buf + ((PERMK ? (4 * g + q) : (8 * g + q)) * P + 8 * p) + (kbase * P + 32 * cb);
    const v4i16 lo = __builtin_amdgcn_ds_read_tr16_b64_v4i16((LAS v4i16*)a0);
    const v4i16 hi = __builtin_amdgcn_ds_read_tr16_b64_v4i16((LAS v4i16*)(a0 + (PERMK ? 16 : 4) * P));
    const f16x4 l = __builtin_bit_cast(f16x4, lo), h = __builtin_bit_cast(f16x4, hi);
    return (f16x8){l[0], l[1], l[2], l[3], h[0], h[1], h[2], h[3]};
}
#ifndef STAG_SLEEP
#define STAG_SLEEP 1
#endif
#define STAGGER(w) do { if (STAG_SLEEP > 0 && (w) >= 4) __builtin_amdgcn_s_sleep(STAG_SLEEP); } while (0)
#define LBAR() do { asm volatile("s_waitcnt lgkmcnt(0)" ::: "memory"); __builtin_amdgcn_s_barrier(); asm volatile("" ::: "memory"); } while (0)
__device__ __forceinline__ u32x4 widen2(u32x2 A, u32x2 B) {
    const auto rx = __builtin_amdgcn_permlane16_swap(A.x, B.x, false, false), ry = __builtin_amdgcn_permlane16_swap(A.y, B.y, false, false);
    return (u32x4){rx[0], ry[0], rx[1], ry[1]};
}
__device__ __forceinline__ void unwiden2(u32x4 W, u32x2& A, u32x2& B) {
    const auto rx = __builtin_amdgcn_permlane16_swap(W.x, W.z, false, false), ry = __builtin_amdgcn_permlane16_swap(W.y, W.w, false, false);
    A.x = rx[0]; B.x = rx[1]; A.y = ry[0]; B.y = ry[1];
}
#define MFMA16(a, b, c) __builtin_amdgcn_mfma_f32_16x16x32_f16((a), (b), (c), 0, 0, 0)

constexpr int CONV_TOTAL = 64512, CONV_P0_END = 8192, CONV_RS0_END = 36352;
struct ConvSrc { const float *g_mix, *g_ffn, *w_ret_in, *w_ret_out, *g_kv, *w_kv, *w_att_q, *w_att_out, *w_ffn_in, *w_ffn_out; unsigned char* ws; };
struct CvItem { const float* W; const float* gain; f16* WT; int K, N, mode, bf, k0, n0; };
__device__ __forceinline__ CvItem cv_decode(const ConvSrc& c, int item) {
    CvItem t; int r, l; t.bf = 0;
    if (item < 33280) { l = item / 16640; r = item - l * 16640;
        if (r < 6144)       { t.W = c.w_ret_in + (size_t)l * DM * NRETIN; t.K = DM; t.N = NRETIN; t.gain = c.g_mix + l * DM; t.WT = (f16*)(c.ws + WS_W_RETIN) + (size_t)l * NRETIN * DM; t.mode = 0; }
        else if (r < 8192)  { r -= 6144; t.W = c.w_ret_out + (size_t)l * 4096 * DM; t.K = 4096; t.N = DM; t.gain = nullptr; t.WT = (f16*)(c.ws + WS_W_RETOUT) + (size_t)l * DM * 4096; t.mode = 0; t.bf = 1; }
        else if (r < 13824) { r -= 8192; t.W = c.w_ffn_in + (size_t)l * DM * 2 * FF; t.K = DM; t.N = 2 * FF; t.gain = c.g_ffn + l * DM; t.WT = (f16*)(c.ws + WS_W_FFNIN) + (size_t)l * 2 * FF * DM; t.mode = 1; t.bf = 1; }
        else                { r -= 13824; t.W = c.w_ffn_out + (size_t)l * FF * DM; t.K = FF; t.N = DM; t.gain = nullptr; t.WT = (f16*)(c.ws + WS_W_FFNOUT) + (size_t)l * DM * FF; t.mode = 0; t.bf = 1; }
    } else if (item < 39424) { r = item - 33280; t.W = c.w_kv; t.K = DM; t.N = NKV; t.gain = c.g_kv; t.WT = (f16*)(c.ws + WS_W_KV); t.mode = 0;
    } else { const int i3 = item - 39424; const int j = i3 / 12544; r = i3 - j * 12544; l = 2 + j;
        if (r < 3072)      { t.W = c.w_att_q + (size_t)j * DM * NATT; t.K = DM; t.N = NATT; t.gain = c.g_mix + l * DM; t.WT = (f16*)(c.ws + WS_W_Q) + (size_t)j * NATT * DM; t.mode = 0; }
        else if (r < 4096) { r -= 3072; t.W = c.w_att_out + (size_t)j * DM * DM; t.K = DM; t.N = DM; t.gain = nullptr; t.WT = (f16*)(c.ws + WS_W_ATTOUT) + (size_t)j * DM * DM; t.mode = 0; t.bf = 1; }
        else if (r < 9728) { r -= 4096; t.W = c.w_ffn_in + (size_t)l * DM * 2 * FF; t.K = DM; t.N = 2 * FF; t.gain = c.g_ffn + l * DM; t.WT = (f16*)(c.ws + WS_W_FFNIN) + (size_t)l * 2 * FF * DM; t.mode = 1; t.bf = 1; }
        else               { r -= 9728; t.W = c.w_ffn_out + (size_t)l * FF * DM; t.K = FF; t.N = DM; t.gain = nullptr; t.WT = (f16*)(c.ws + WS_W_FFNOUT) + (size_t)l * DM * FF; t.mode = 0; t.bf = 1; }
    }
    const int nnb = t.N / 64, kb = r / nnb; t.k0 = kb * 64; t.n0 = (r - kb * nnb) * 64;
    return t;
}
__device__ __forceinline__ void cv_load(const CvItem& t, float (&v)[64], int lane) {
    const float* p = t.W + (size_t)t.k0 * t.N + t.n0 + lane;
#pragma unroll
    for (int kk = 0; kk < 64; ++kk) v[kk] = p[(size_t)kk * t.N];
}
__device__ __forceinline__ void cv_store(const CvItem& t, float (&v)[64], LAS unsigned* scr, int lane) {
    if (t.gain) {
#pragma unroll
        for (int kk = 0; kk < 64; ++kk) v[kk] *= t.gain[t.k0 + kk]; }
    if (t.bf) {
#pragma unroll
        for (int p = 0; p < 32; ++p) scr[lane * 33 + p] = pk2bf(v[2 * p], v[2 * p + 1]);
    } else {
#pragma unroll
        for (int p = 0; p < 32; ++p) scr[lane * 33 + p] = pk2h(v[2 * p], v[2 * p + 1]); }
    LDS_WAIT(); asm volatile("" ::: "memory");
    const int c = lane & 7;
#pragma unroll
    for (int j = 0; j < 8; ++j) { const int n = (lane >> 3) + 8 * j; const LAS unsigned* sp = scr + n * 33 + 4 * c;
        u32x4 o; o.x = sp[0]; o.y = sp[1]; o.z = sp[2]; o.w = sp[3];
        const int ns = t.n0 + n; int row = ns;
        if (t.mode == 1) { row = (ns < FF) ? (256 * (ns >> 7) + (ns & 127)) : (256 * ((ns - FF) >> 7) + 128 + ((ns - FF) & 127)); }
        *(u32x4*)(t.WT + (size_t)row * t.K + t.k0 + 8 * c) = o; }
    LDS_WAIT(); asm volatile("" ::: "memory");
}
__device__ __forceinline__ void conv_all(const ConvSrc c, int lo, int hi, int gw, int NGW, LAS unsigned* scr, int lane) {
    int it = lo + gw;
    if (it >= hi) return;
    float va[64], vb[64];
    CvItem ca = cv_decode(c, it), cb = ca;
    cv_load(ca, va, lane);
    for (;;) {
        const bool hb = (it + NGW) < hi;
        if (hb) { cb = cv_decode(c, it + NGW); cv_load(cb, vb, lane); }
        cv_store(ca, va, scr, lane);
        if (!hb) break;
        it += NGW;
        const bool ha = (it + NGW) < hi;
        if (ha) { ca = cv_decode(c, it + NGW); cv_load(ca, va, lane); }
        cv_store(cb, vb, scr, lane);
        if (!ha) break;
        it += NGW;
    }
}
__device__ __forceinline__ void sincos_d(double a, double& s, double& c) {
    const double k = __builtin_rint(a * 0.63661977236758134308);
    double r = __builtin_fma(-k, 1.57079632679489655800e+00, a); r = __builtin_fma(-k, 6.12323399573676603587e-17, r);
    const double r2 = r * r;
    double ps = -1.0 / 121645100408832000.0;
    ps = ps * r2 + 1.0 / 355687428096000.0;  ps = ps * r2 - 1.0 / 1307674368000.0; ps = ps * r2 + 1.0 / 6227020800.0; ps = ps * r2 - 1.0 / 39916800.0;
    ps = ps * r2 + 1.0 / 362880.0; ps = ps * r2 - 1.0 / 5040.0; ps = ps * r2 + 1.0 / 120.0; ps = ps * r2 - 1.0 / 6.0; ps = ps * r2 + 1.0;
    const double sn = ps * r;
    double pc = 1.0 / 6402373705728000.0;
    pc = pc * r2 - 1.0 / 20922789888000.0; pc = pc * r2 + 1.0 / 87178291200.0; pc = pc * r2 - 1.0 / 479001600.0; pc = pc * r2 + 1.0 / 3628800.0;
    pc = pc * r2 - 1.0 / 40320.0; pc = pc * r2 + 1.0 / 720.0; pc = pc * r2 - 1.0 / 24.0; pc = pc * r2 + 0.5; const double cs = 1.0 - pc * r2;
    const int q = ((int)k) & 3;
    s = (q == 0) ? sn : (q == 1) ? cs : (q == 2) ? -sn : -cs;
    c = (q == 0) ? cs : (q == 1) ? -sn : (q == 2) ? -cs : sn;
}

template <int NET>
__device__ __forceinline__ void ret_state_phase(LAS unsigned char* lds, const f16* __restrict__ Z, f16* __restrict__ ST, int unit0, int ustride) {
    constexpr int NS = 32 / NET, VP = 32 * NET + 32, NVR = NET / 2, KP = 288, KTB = 128 * KP;
    const int tid = opaque_tid();
    const int lane = tid & 63, w = __builtin_amdgcn_readfirstlane(tid >> 6), li = lane & 15, g = lane >> 4, q = li >> 2, p = li & 3;
    LAS unsigned char* kimg = lds; LAS unsigned char* vimg = lds + 2 * KTB;
    for (int u = unit0; u < BATCH * RH * NS; u += ustride) {
        const int b = u / (RH * NS), h = (u / NS) % RH, es = u % NS;
        const float l2g = log2f(1.0f - exp2f(-5.0f - (float)h)), cdec = exp2f(128.0f * l2g);
        const f16* zb = Z + (size_t)b * SEQ * NRETIN;
        const f16* ksrc = zb + 2048 + h * 256; const f16* vsrc = zb + 4096 + h * 512 + es * (16 * NET);
        f16* stb = ST + (size_t)((b * RH + h) * NCH) * (RDV * RDK) + (size_t)(es * 16 * NET) * RDK;
        const float vscale = exp2f((float)(127 - (tid >> 2)) * l2g);
        const unsigned vo = (unsigned)((tid >> 2) * NRETIN + (tid & 3) * 8 * NVR) * 2u;
        f32x4 R[2][NET];
#pragma unroll
        for (int a = 0; a < 2; ++a)
#pragma unroll
            for (int c2 = 0; c2 < NET; ++c2) R[a][c2] = (f32x4){0.f, 0.f, 0.f, 0.f};
        u32x4 kr[3][2][4], vr[3][NVR];
#define RS_LOAD(set, c) do { const f16* kc = ksrc + (size_t)(c) * RC * NRETIN; tile_load(kr[set][0], kc, NRETIN * 2, tid); tile_load(kr[set][1], kc + 128, NRETIN * 2, tid); \
            _Pragma("unroll") for (int i = 0; i < NVR; ++i) vr[set][i] = *(const u32x4*)((const char*)(vsrc + (size_t)(c) * RC * NRETIN) + vo + 16u * i); } while (0)
#define RS_STEP(set, c) do { \
            LBAR(); \
            tile_store<KP>(kimg, kr[set][0], tid); tile_store<KP>(kimg + KTB, kr[set][1], tid); \
            _Pragma("unroll") for (int i = 0; i < NVR; ++i) { const f16x8 vv = __builtin_bit_cast(f16x8, vr[set][i]); f16x8 o; \
              _Pragma("unroll") for (int j = 0; j < 8; ++j) o[j] = (f16)((float)vv[j] * vscale); \
              *(LAS f16x8*)(vimg + (tid >> 2) * VP + (tid & 3) * 16 * NVR + 16 * i) = o; } \
            LBAR(); STAGGER(w); \
            RS_LOAD(set, ((c) + 3 < NCH) ? (c) + 3 : NCH - 1);        \
            { f16* sp = stb + (size_t)(c) * (RDV * RDK);                  \
                _Pragma("unroll") for (int et = 0; et < NET; ++et) { u32x2 o0, o1; o0.x = pk2h(R[0][et][0], R[0][et][1]); o0.y = pk2h(R[0][et][2], R[0][et][3]); o1.x = pk2h(R[1][et][0], R[1][et][1]); o1.y = pk2h(R[1][et][2], R[1][et][3]); \
                    *(u32x4*)(sp + (size_t)(16 * et + li) * RDK + 32 * w + 16 * (g & 1) + 8 * (g >> 1)) = widen2(o0, o1); } } \
            _Pragma("unroll") for (int dt = 0; dt < 2; ++dt) _Pragma("unroll") for (int et = 0; et < NET; ++et) R[dt][et] = R[dt][et] * cdec; \
            const LAS unsigned char* kt = kimg + (w >> 2) * KTB; \
            _Pragma("unroll") for (int ks = 0; ks < 4; ++ks) { \
                f16x8 bf[NET]; \
                _Pragma("unroll") for (int et = 0; et < NET; ++et) { \
                    const LAS unsigned char* a0 = vimg + (32 * ks + 4 * g + q) * VP + 32 * et + 8 * p; \
                    const v4i16 lo = __builtin_amdgcn_ds_read_tr16_b64_v4i16((LAS v4i16*)a0), hi = __builtin_amdgcn_ds_read_tr16_b64_v4i16((LAS v4i16*)(a0 + 16 * VP)); \
                    const f16x4 l = __builtin_bit_cast(f16x4, lo), hh = __builtin_bit_cast(f16x4, hi); \
                    bf[et] = (f16x8){l[0], l[1], l[2], l[3], hh[0], hh[1], hh[2], hh[3]}; } \
                _Pragma("unroll") for (int dt = 0; dt < 2; ++dt) { const f16x8 af = frag_tr<true, KP>(kt, 32 * ks, 2 * (w & 3) + dt, li, g); \
                    _Pragma("unroll") for (int et = 0; et < NET; ++et) R[dt][et] = MFMA16(af, bf[et], R[dt][et]); } } \
        } while (0)
        RS_LOAD(0, 0); RS_LOAD(1, 1); RS_LOAD(2, 2);
        RS_STEP(0, 0); RS_STEP(1, 1); RS_STEP(2, 2); RS_STEP(0, 3);
        for (int c = 4; c < NCH; c += 3) { RS_STEP(1, c); RS_STEP(2, c + 1); RS_STEP(0, c + 2); }
#undef RS_LOAD
#undef RS_STEP
        LBAR();
    }
}

struct RoUnit { const f16* zc; const f16* stc; const f16* ksrc; const f16* vsrc; int h; bool hasr; size_t tok0; };
__device__ __forceinline__ RoUnit ro_decode(int u, const f16* Z, const f16* ST) {
    RoUnit r; const int b = u >> 9, h = (u >> 6) & 7, c = u & 63;
    r.h = h; r.hasr = c > 0; r.tok0 = (size_t)b * SEQ + (size_t)c * RC; r.zc = Z + r.tok0 * NRETIN;
    r.stc = ST + (size_t)((b * RH + h) * NCH + c) * (RDV * RDK); r.ksrc = r.zc + 2048 + h * 256; r.vsrc = r.zc + 4096 + h * 512;
    return r;
}
__device__ __forceinline__ void ret_out_phase(LAS unsigned char* lds, const f16* __restrict__ Z, const f16* __restrict__ ST, f16* __restrict__ Y, int G, int bid) {
    constexpr int NU = BATCH * RH * NCH;
    if (bid >= NU) return;
    RoUnit cur = ro_decode(bid, Z, ST);
    f16x8 Qf[8];
    u32x4 pre[2][4];
    int tid = opaque_tid(), lane = tid & 63, li = lane & 15, g = lane >> 4;
    const int w = __builtin_amdgcn_readfirstlane(tid >> 6);
    unsigned qo = (unsigned)((16 * w + li) * NRETIN + 8 * g) * 2u;
#define RO_LOADQ(un) do { const char* qb_ = (const char*)((un).zc + (un).h * 256); _Pragma("unroll") for (int ks = 0; ks < 8; ++ks) Qf[ks] = *(const f16x8*)(qb_ + (qo + 64u * ks)); } while (0)
#define RO_LDK(set, un, kd)      tile_load(pre[set], (un).ksrc + (kd) * 128, NRETIN * 2, tid)
#define RO_LDR(set, un, eb, kd)  tile_load(pre[set], (un).stc + (size_t)((eb) * 128) * RDK + (kd) * 128, RDK * 2, tid)
#define RO_LDV(set, un, eb)      tile_load(pre[set], (un).vsrc + (eb) * 128, NRETIN * 2, tid)
    RO_LOADQ(cur); RO_LDK(0, cur, 0); RO_LDK(1, cur, 1);
    for (int u = bid; u < NU; u += G) {
        const bool has_next = (u + G) < NU;
        const RoUnit nxt = ro_decode(has_next ? u + G : u, Z, ST);
        const bool hasr = cur.hasr;
        tid = opaque_tid(); lane = tid & 63; li = lane & 15; g = lane >> 4;
        qo = (unsigned)((16 * w + li) * NRETIN + 8 * g) * 2u;
        LAS unsigned char* parkL = lds + 2 * TILE_B + w * 8192 + lane * 8;
        const float l2g = log2f(1.0f - exp2f(-5.0f - (float)cur.h));
        f16x8 Sf[4];
        {
            f32x4 St[8];
#pragma unroll
            for (int jt = 0; jt < 8; ++jt) St[jt] = (f32x4){0.f, 0.f, 0.f, 0.f};
#pragma unroll
            for (int kd = 0; kd < 2; ++kd) {
                LAS unsigned char* buf = lds + kd * TILE_B;
                tile_store(buf, pre[kd], tid); LBAR(); STAGGER(w);
                if (hasr) RO_LDR(kd, cur, kd, 0); else RO_LDV(kd, cur, kd);
#pragma unroll
                for (int jt = 0; jt < 8; ++jt) if (jt <= w)
#pragma unroll
                    for (int ks = 0; ks < 4; ++ks) { St[jt] = MFMA16(frag_row(buf, jt, ks, li, g), Qf[4 * kd + ks], St[jt]); if (ks == 3) __builtin_amdgcn_sched_barrier(0); }
            }
            const int tq = opaque_tid(), i = 16 * w + (tq & 15), gq = (tq >> 4) & 3;
#pragma unroll
            for (int jt = 0; jt < 8; ++jt)
#pragma unroll
                for (int r = 0; r < 4; ++r) { const int j = 16 * jt + 4 * gq + r; St[jt][r] = (i >= j) ? St[jt][r] * __builtin_amdgcn_exp2f((float)(i - j) * l2g) : 0.f; }
#pragma unroll
            for (int s = 0; s < 4; ++s) Sf[s] = (f16x8){(f16)St[2 * s][0], (f16)St[2 * s][1], (f16)St[2 * s][2], (f16)St[2 * s][3], (f16)St[2 * s + 1][0], (f16)St[2 * s + 1][1], (f16)St[2 * s + 1][2], (f16)St[2 * s + 1][3]};
        }
        const float qd = __builtin_amdgcn_exp2f((float)(16 * w + li + 1) * l2g);
        float sq = 0.f;
        f32x4 acc[16];
#pragma unroll
        for (int hf = 0; hf < 2; ++hf) {
#pragma unroll
            for (int a = 0; a < 16; ++a) acc[a] = (f32x4){0.f, 0.f, 0.f, 0.f};
            if (hasr) {
#pragma unroll
                for (int rr = 0; rr < 4; ++rr) {
                    LAS unsigned char* buf = lds + (rr & 1) * TILE_B;
                    tile_store(buf, pre[rr & 1], tid); LBAR(); STAGGER(w);
                    if (rr < 2) RO_LDR(rr & 1, cur, 2 * hf + (rr & 1), 1); else RO_LDV(rr & 1, cur, 2 * hf + (rr & 1));
                    const int ebl = rr & 1, kd = rr >> 1;
#pragma unroll
                    for (int et = 0; et < 8; ++et)
#pragma unroll
                        for (int ks = 0; ks < 4; ++ks) { acc[8 * ebl + et] = MFMA16(frag_row(buf, et, ks, li, g), Qf[4 * kd + ks], acc[8 * ebl + et]); if (ks == 3) __builtin_amdgcn_sched_barrier(0); }
                }
#pragma unroll
                for (int a = 0; a < 16; ++a) acc[a] = acc[a] * qd;
            }
#pragma unroll
            for (int ebl = 0; ebl < 2; ++ebl) {
                LAS unsigned char* buf = lds + ebl * TILE_B;
                tile_store(buf, pre[ebl], tid); LBAR(); STAGGER(w);
                if (hf == 0) { if (hasr) RO_LDR(ebl, cur, 2 + ebl, 0); else RO_LDV(ebl, cur, 2 + ebl); }
                else if (has_next) RO_LDK(ebl, nxt, ebl);
#pragma unroll
                for (int et = 0; et < 8; ++et)
#pragma unroll
                    for (int s = 0; s < 4; ++s) { if (2 * s <= w) acc[8 * ebl + et] = MFMA16(frag_tr<true>(buf, 32 * s, et, li, g), Sf[s], acc[8 * ebl + et]); if (s == 3) __builtin_amdgcn_sched_barrier(0); }
            }
#pragma unroll
            for (int a = 0; a < 16; ++a) sq += (acc[a][0] * acc[a][0] + acc[a][1] * acc[a][1]) + (acc[a][2] * acc[a][2] + acc[a][3] * acc[a][3]);
            if (hf == 0) {
#pragma unroll
                for (int a = 0; a < 16; ++a) { u32x2 o; o.x = pk2h(acc[a][0], acc[a][1]); o.y = pk2h(acc[a][2], acc[a][3]); *(LAS u32x2*)(parkL + 512 * a) = o; }
            }
        }
        sq += __shfl_xor(sq, 16); sq += __shfl_xor(sq, 32);
        const float rs = __builtin_amdgcn_rsqf(sq * (1.0f / RDV) + NORM_EPS);
        const int t2 = opaque_tid(), li2 = t2 & 15, g2 = (t2 >> 4) & 3;
        const unsigned cw = 16 * (g2 & 1) + 8 * (g2 >> 1);
        const unsigned go = (unsigned)((16 * w + li2) * NRETIN) + cw, yo = (unsigned)((16 * w + li2) * 4096) + cw;
        const f16* gp = (cur.zc + 8192 + cur.h * 512) + go; f16* yp = (Y + cur.tok0 * 4096 + cur.h * 512) + yo;
        u32x4 gw[8];
#pragma unroll
        for (int a = 0; a < 8; ++a) gw[a] = *(const u32x4*)(gp + 32 * a);
#pragma unroll
        for (int a = 0; a < 8; ++a) { u32x2 g0, g1; unwiden2(gw[a], g0, g1); const f16x4 ga = __builtin_bit_cast(f16x4, g0), gb = __builtin_bit_cast(f16x4, g1);
            const f16x4 pa = __builtin_bit_cast(f16x4, *(const LAS u32x2*)(parkL + 512 * (2 * a))), pb = __builtin_bit_cast(f16x4, *(const LAS u32x2*)(parkL + 512 * (2 * a + 1)));
            u32x2 o0, o1; o0.x = pk2bf((float)pa[0] * rs * (float)ga[0], (float)pa[1] * rs * (float)ga[1]); o0.y = pk2bf((float)pa[2] * rs * (float)ga[2], (float)pa[3] * rs * (float)ga[3]);
            o1.x = pk2bf((float)pb[0] * rs * (float)gb[0], (float)pb[1] * rs * (float)gb[1]); o1.y = pk2bf((float)pb[2] * rs * (float)gb[2], (float)pb[3] * rs * (float)gb[3]);
            *(u32x4*)(yp + 32 * a) = widen2(o0, o1); }
#pragma unroll
        for (int a = 0; a < 8; ++a) gw[a] = *(const u32x4*)(gp + 256 + 32 * a);
#pragma unroll
        for (int a = 0; a < 8; ++a) { u32x2 g0, g1; unwiden2(gw[a], g0, g1); const f16x4 ga = __builtin_bit_cast(f16x4, g0), gb = __builtin_bit_cast(f16x4, g1);
            const f32x4 av = acc[2 * a], bv = acc[2 * a + 1];
            u32x2 o0, o1; o0.x = pk2bf(av[0] * rs * (float)ga[0], av[1] * rs * (float)ga[1]); o0.y = pk2bf(av[2] * rs * (float)ga[2], av[3] * rs * (float)ga[3]);
            o1.x = pk2bf(bv[0] * rs * (float)gb[0], bv[1] * rs * (float)gb[1]); o1.y = pk2bf(bv[2] * rs * (float)gb[2], bv[3] * rs * (float)gb[3]);
            *(u32x4*)(yp + 256 + 32 * a) = widen2(o0, o1); }
        __builtin_amdgcn_sched_barrier(0);
        if (has_next) RO_LOADQ(nxt);
        cur = nxt;
    }
#undef RO_LOADQ
#undef RO_LDK
#undef RO_LDR
#undef RO_LDV
    LBAR();
}

constexpr int BIAS_ROW = 160, BIAS_PAD = 16;
struct AttUnit { const f16* k0; const f16* k1; const f16* q; unsigned kstride; int gi, hs, d, lse0; bool hasp, cont; size_t tok0; };
__device__ __forceinline__ AttUnit att_decode(int k, int bid, int G, const f16* KV, const f16* QA) {
    AttUnit a; const int u = (bid + (k >> 2) * G) * 4 + (k & 3);
    const int gi = u >> 11, rem = u & 2047, b = rem >> 10, hs = (rem >> 6) & 15, rb = rem & 63, dsh = 2 * gi, d = 1 << dsh, nb = rb & ((64 >> dsh) - 1), r = rb >> (6 - dsh);
    a.gi = gi; a.hs = hs; a.d = d; a.hasp = nb > 0; a.cont = (k & 3) != 0; a.tok0 = (size_t)b * SEQ + r + (size_t)(nb * 128) * d;
    a.lse0 = ((gi * 16 + hs) * BATCH + b) * SEQ + r * (SEQ >> dsh) + nb * 128;
    a.k1 = KV + a.tok0 * NKV + gi * 2048 + hs * 128; a.k0 = a.k1 - (size_t)128 * d * NKV; a.kstride = (unsigned)d * NKV * 2u;
    a.q = QA + a.tok0 * NATT + gi * 2048 + hs * 128;
    return a;
}
__device__ __forceinline__ void att_phase(const bool MERGE, LAS unsigned char* lds, const f16* __restrict__ KV, const f16* __restrict__ QA, f16* OG, float* LSE,
                                          const float* __restrict__ biasT, int G, int bid0, int run0, int nrun, f16* __restrict__ O16) {
    const int bid = run0 + bid0;
    const int tid = opaque_tid();
    const int lane = tid & 63, w = __builtin_amdgcn_readfirstlane(tid >> 6), li = lane & 15, g = lane >> 4;
    LAS float* biasL = (LAS float*)(lds + 4 * TILE_B);
    const int nk = (bid0 < nrun) ? 4 * ((nrun - 1 - bid0) / G + 1) : 0;
    if (nk == 0) return;
    AttUnit cur = att_decode(0, bid, G, KV, QA);
    u32x4 A[4], B[4]; f16x8 Qn[4]; float bn = 0.f;
    const int bc = tid - BIAS_PAD;
    { const char* qb = (const char*)cur.q; const unsigned qo = (unsigned)((16 * w + li) * cur.d) * (unsigned)(NATT * 2) + 16u * g;
#pragma unroll
      for (int ks = 0; ks < 4; ++ks) Qn[ks] = *(const f16x8*)(qb + (qo + 64u * ks)); }
    if (bc >= 0 && bc <= 128) bn = biasT[(cur.gi * 16 + cur.hs) * BIAS_PITCH + bc];
    __builtin_amdgcn_sched_barrier(0);
    if (cur.hasp) tile_load(A, cur.k0, cur.kstride, tid);
    tile_load(B, cur.k1, cur.kstride, tid);
    int sel = 0;
    for (int k = 0; k < nk; ++k) {
        const bool has_next = (k + 1) < nk;
        const AttUnit nxt = att_decode(has_next ? k + 1 : k, bid, G, KV, QA);
        f16x8 Qf[4];
#pragma unroll
        for (int ks = 0; ks < 4; ++ks) Qf[ks] = Qn[ks];
        const bool hasp = cur.hasp, fresh = !cur.cont;
        if (cur.cont) sel ^= 1;
        LAS unsigned char* bKc = lds + sel * TILE_B; LAS unsigned char* bKp = lds + (sel ^ 1) * TILE_B;
        LAS unsigned char* bVc = lds + (2 + sel) * TILE_B; LAS unsigned char* bVp = lds + (2 + (sel ^ 1)) * TILE_B;
        if (fresh && hasp) tile_store(bKp, A, tid);
        tile_store(bKc, B, tid);
        if (tid < BIAS_ROW) biasL[tid] = bn;
        LBAR(); STAGGER(w);
        if (fresh && hasp) tile_load(A, cur.k0 + NATT, cur.kstride, tid);
        tile_load(B, cur.k1 + NATT, cur.kstride, tid);
        f32x4 St[16];
#pragma unroll
        for (int t = 0; t < 16; ++t) St[t] = (f32x4){0.f, 0.f, 0.f, 0.f};
        if (hasp) {
#pragma unroll
            for (int T = 0; T < 8; ++T) if (T >= w) {
#pragma unroll
                for (int ks = 0; ks < 4; ++ks) St[T] = MFMA16(frag_row(bKp, T, ks, li, g), Qf[ks], St[T]);
                __builtin_amdgcn_sched_barrier(0); }
        }
#pragma unroll
        for (int T = 0; T < 8; ++T) if (T <= w) {
#pragma unroll
            for (int ks = 0; ks < 4; ++ks) St[8 + T] = MFMA16(frag_row(bKc, T, ks, li, g), Qf[ks], St[8 + T]);
            __builtin_amdgcn_sched_barrier(0); }
        const int tq = opaque_tid(), liq = tq & 15, gq = (tq >> 4) & 3;
        const LAS float* bl = biasL + BIAS_PAD + (liq - 4 * gq);
        float mx = -INFINITY;
        if (hasp) {
#pragma unroll
            for (int T = 0; T < 8; ++T) if (T >= w) { const bool diag = (T == w);
#pragma unroll
                for (int rg = 0; rg < 4; ++rg) { float sv = St[T][rg] + bl[128 + 16 * (w - T) - rg]; if (diag && (4 * gq + rg < liq)) sv = -INFINITY; St[T][rg] = sv; mx = fmaxf(mx, sv); } }
        }
#pragma unroll
        for (int T = 0; T < 8; ++T) if (T <= w) { const bool diag = (T == w);
#pragma unroll
            for (int rg = 0; rg < 4; ++rg) { float sv = St[8 + T][rg] + bl[16 * (w - T) - rg]; if (diag && (4 * gq + rg > liq)) sv = -INFINITY; St[8 + T][rg] = sv; mx = fmaxf(mx, sv); } }
        mx = fmaxf(mx, __shfl_xor(mx, 16)); mx = fmaxf(mx, __shfl_xor(mx, 32));
        float den = 0.f;
        if (hasp) {
#pragma unroll
            for (int T = 0; T < 8; ++T) if (T >= w) {
#pragma unroll
                for (int rg = 0; rg < 4; ++rg) { const float pv = __builtin_amdgcn_exp2f(St[T][rg] - mx); St[T][rg] = pv; den += pv; } }
        }
#pragma unroll
        for (int T = 0; T < 8; ++T) if (T <= w) {
#pragma unroll
            for (int rg = 0; rg < 4; ++rg) { const float pv = __builtin_amdgcn_exp2f(St[8 + T][rg] - mx); St[8 + T][rg] = pv; den += pv; } }
        den += __shfl_xor(den, 16); den += __shfl_xor(den, 32);
        f16x8 Pf[8];
#pragma unroll
        for (int s = 0; s < 8; ++s) Pf[s] = (f16x8){(f16)St[2 * s][0], (f16)St[2 * s][1], (f16)St[2 * s][2], (f16)St[2 * s][3], (f16)St[2 * s + 1][0], (f16)St[2 * s + 1][1], (f16)St[2 * s + 1][2], (f16)St[2 * s + 1][3]};
        if (fresh && hasp) tile_store(bVp, A, tid);
        tile_store(bVc, B, tid);
        LBAR(); STAGGER(w);
        if (has_next) {
            const char* qb = (const char*)nxt.q; const unsigned qo = (unsigned)((16 * w + li) * nxt.d) * (unsigned)(NATT * 2) + 16u * g;
#pragma unroll
            for (int ks = 0; ks < 4; ++ks) Qn[ks] = *(const f16x8*)(qb + (qo + 64u * ks));
            if (bc >= 0 && bc <= 128) bn = biasT[(nxt.gi * 16 + nxt.hs) * BIAS_PITCH + bc];
            __builtin_amdgcn_sched_barrier(0);
            if (!nxt.cont && nxt.hasp) tile_load(A, nxt.k0, nxt.kstride, tid);
            tile_load(B, nxt.k1, nxt.kstride, tid);
        }
        u32x4 mo1[4], mo2[4]; float ml1 = 0.f, ml2 = 0.f;
        if (MERGE) {
            const int t = (cur.lse0 & (SEQ - 1)) + 16 * w + liq, hb = cur.lse0 - (cur.lse0 & (SEQ - 1));
            const int r1 = hb + 16 * BATCH * SEQ + (t & 3) * (SEQ >> 2) + (t >> 2), r2 = hb + 32 * BATCH * SEQ + (t & 15) * (SEQ >> 4) + (t >> 4);
            const unsigned cw = 16 * (gq & 1) + 8 * (gq >> 1);
            const f16* p1 = OG + (size_t)r1 * 128 + cw; const f16* p2 = OG + (size_t)r2 * 128 + cw;
#pragma unroll
            for (int j = 0; j < 4; ++j) { mo1[j] = *(const u32x4*)(p1 + 32 * j); mo2[j] = *(const u32x4*)(p2 + 32 * j); }
            ml1 = LSE[r1]; ml2 = LSE[r2];
        }
        f32x4 O[8];
#pragma unroll
        for (int et = 0; et < 8; ++et) O[et] = (f32x4){0.f, 0.f, 0.f, 0.f};
        if (hasp) {
#pragma unroll
            for (int s = 0; s < 4; ++s) if (2 * s + 1 >= w) {
#pragma unroll
                for (int et = 0; et < 8; ++et) O[et] = MFMA16(frag_tr<true>(bVp, 32 * s, et, li, g), Pf[s], O[et]);
                __builtin_amdgcn_sched_barrier(0); }
        }
#pragma unroll
        for (int s = 0; s < 4; ++s) if (2 * s <= w) {
#pragma unroll
            for (int et = 0; et < 8; ++et) O[et] = MFMA16(frag_tr<true>(bVc, 32 * s, et, li, g), Pf[4 + s], O[et]);
            __builtin_amdgcn_sched_barrier(0); }
        const float inv = 1.0f / den;
        if (!MERGE) {
            f16* op = OG + (size_t)(cur.lse0 + 16 * w + liq) * 128 + 16 * (gq & 1) + 8 * (gq >> 1);
#pragma unroll
            for (int et = 0; et < 8; et += 2) { u32x2 o0, o1; o0.x = pk2h(O[et][0] * inv, O[et][1] * inv); o0.y = pk2h(O[et][2] * inv, O[et][3] * inv); o1.x = pk2h(O[et + 1][0] * inv, O[et + 1][1] * inv); o1.y = pk2h(O[et + 1][2] * inv, O[et + 1][3] * inv);
                *(u32x4*)(op + 16 * et) = widen2(o0, o1); }
            if (gq == 0) LSE[cur.lse0 + 16 * w + liq] = (mx + __log2f(den)) * 0.6931471805599453f;
        } else {
            const float l0 = (mx + __log2f(den)) * 0.6931471805599453f, mm = fmaxf(l0, fmaxf(ml1, ml2));
            float w0 = __expf(l0 - mm), w1 = __expf(ml1 - mm), w2 = __expf(ml2 - mm); const float iw = 1.0f / (w0 + w1 + w2); w0 *= iw * inv; w1 *= iw; w2 *= iw;
            f16* op = O16 + (cur.tok0 + (size_t)(16 * w + liq)) * DM + cur.hs * 128 + 16 * (gq & 1) + 8 * (gq >> 1);
#pragma unroll
            for (int et = 0; et < 8; et += 2) { float c[8];
#pragma unroll
                for (int i = 0; i < 4; ++i) { const float fa = O[et][i], fb = O[et + 1][i]; const auto rr = __builtin_amdgcn_permlane16_swap(__builtin_bit_cast(unsigned, fa), __builtin_bit_cast(unsigned, fb), false, false);
                    c[i] = __builtin_bit_cast(float, (unsigned)rr[0]); c[4 + i] = __builtin_bit_cast(float, (unsigned)rr[1]); }
                const f16x8 a1 = __builtin_bit_cast(f16x8, mo1[et >> 1]), a2 = __builtin_bit_cast(f16x8, mo2[et >> 1]);
#pragma unroll
                for (int e = 0; e < 8; ++e) c[e] = w0 * c[e] + w1 * (float)a1[e] + w2 * (float)a2[e];
                u32x4 o; o.x = pk2bf(c[0], c[1]); o.y = pk2bf(c[2], c[3]); o.z = pk2bf(c[4], c[5]); o.w = pk2bf(c[6], c[7]);
                *(u32x4*)(op + 16 * et) = o; }
        }
        cur = nxt;
    }
    LBAR();
}
struct Args { const float* in[13]; float* out; unsigned char* ws; int ph_lo, ph_hi; };
constexpr int N_PHASES = 26;

__global__ void __launch_bounds__(NWAVES * 64, 2) yoco_fwd(Args args) {
    extern __shared__ __attribute__((aligned(16))) unsigned char lds_raw[];
    LAS unsigned char* lds = (LAS unsigned char*)lds_raw;
    volatile LAS unsigned* MISC = (volatile LAS unsigned*)(lds + MISC_OFF);
    const int G = gridDim.x, bid = blockIdx.x;
    const int vcu = (G % 8 == 0) ? (bid % 8) * (G / 8) + bid / 8 : bid;
    unsigned char* ws = args.ws;
    unsigned* ctl = (unsigned*)(ws + WS_CTL);
    const float* x_in = args.in[0]; const float* g_mix = args.in[1]; const float* g_ffn = args.in[2]; const float* w_ret_in = args.in[3]; const float* w_ret_out = args.in[4];
    const float* g_kv = args.in[5]; const float* w_kv = args.in[6]; const float* w_att_q = args.in[7]; const float* w_att_out = args.in[8]; const float* rel_bias = args.in[9];
    const float* w_ffn_in = args.in[10]; const float* w_ffn_out = args.in[11]; const float* g_final = args.in[12];
    const ConvSrc cs{g_mix, g_ffn, w_ret_in, w_ret_out, g_kv, w_kv, w_att_q, w_att_out, w_ffn_in, w_ffn_out, ws};
    float* xres = args.out;
    float* ss = (float*)(ws + WS_CTL + CTL_SS);
    float* cosT = (float*)(ws + WS_COS); float* sinT = (float*)(ws + WS_SIN); float* biasT = (float*)(ws + WS_BIAS); float* LSE = (float*)(ws + WS_LSE);
    f16* X16 = (f16*)(ws + WS_X16); f16* XB16 = (f16*)(ws + WS_XB16);
    for (int u = opaque_tid(); u < (LDS_BYTES - LDSCTL_OFF) / 4; u += NWAVES * 64) ((LAS unsigned*)(lds + LDSCTL_OFF))[u] = 0u;
    __syncthreads();
    XcdBarrier bar; bar.bar = ctl + CW_BAR; bar.x = 0; bar.st = nullptr;
    if (MK_N_LAUNCHES == 1) bar = xcd_barrier_post(ctl + CW_BAR, MISC + 8);
    const int lo = args.ph_lo, hi = args.ph_hi;
    int ph = 0;
#define RUN(k) (lo <= (k) && (k) < hi)
#define SEAM(k) do { if ((k) + 1 < hi) xcd_barrier(bar); } while (0)

    if (RUN(ph)) {
#if EN_P0
        for (int rep = 0; rep < REP_P0; ++rep) {
        const int tid = opaque_tid(), lane = tid & 63, wave = __builtin_amdgcn_readfirstlane(tid >> 6);
        const int gw = vcu * NWAVES + wave, NGW = G * NWAVES;
        LAS unsigned* scr = (LAS unsigned*)(lds + wave * 8448);
        conv_all(cs, 0, CONV_P0_END, gw, NGW, scr, lane);
        for (int m = gw; m < M; m += NGW) {
            const f32x4* xr = (const f32x4*)(x_in + (size_t)m * DM) + lane; f32x4 v[8]; float s = 0.f;
#pragma unroll
            for (int j = 0; j < 8; ++j) { v[j] = xr[64 * j]; s += (v[j][0] * v[j][0] + v[j][1] * v[j][1]) + (v[j][2] * v[j][2] + v[j][3] * v[j][3]); }
            s = wave_sum(s); if (lane == 0) ss[m] = s;
            u32x2* o8 = (u32x2*)(X16 + (size_t)m * DM) + lane;
#pragma unroll
            for (int j = 0; j < 8; ++j) { u32x2 o; o.x = pk2h(v[j][0], v[j][1]); o.y = pk2h(v[j][2], v[j][3]); o8[64 * j] = o; }
        }
        const int gt = vcu * 512 + tid, NGT = G * 512;
        for (int idx = gt; idx < SEQ * 128; idx += NGT) {
            const int pos = idx >> 7, i = idx & 127;
            const float inv = (float)(1.0 / exp2((double)i * (1.0 / 127.0) * 13.287712379549449));
            const float ang = __fmul_rn((float)pos, inv);
            double s, c; sincos_d((double)ang, s, c); cosT[idx] = (float)c; sinT[idx] = (float)s;
        }
        for (int idx = gt; idx < 48 * 129; idx += NGT) {
            const int gh = idx / 129, delta = idx - gh * 129, gi = gh >> 4, n = delta << (2 * gi);
            int bk = n;
            if (n >= 16) { bk = 16 + (int)(log((double)n / 16.0) / log(128.0) * 16.0); bk = bk > 31 ? 31 : bk; }
            biasT[gh * BIAS_PITCH + delta] = rel_bias[bk * 48 + gh] * 1.4426950408889634f;
        }
        __syncthreads();
        }
#endif
        SEAM(ph);
    }
    ++ph;

    for (int l = 0; l < 4; ++l) {
        const float* ss_mix = ss + (size_t)(2 * l) * M; float* ss_ffn = ss + (size_t)(2 * l + 1) * M; float* ss_next = ss + (size_t)(2 * l + 2) * M;
        const f16* mixA; const f16* mixB; int mixK;
        f16* HID;
        if (l < 2) {
            f16* Z16 = (f16*)(ws + WS_Z16); f16* STATE = (f16*)(ws + WS_STATE); f16* Yb = (f16*)(ws + WS_Y);
            if (RUN(ph)) {
                pg8::Gemm gm{X16, (const f16*)(ws + WS_W_RETIN) + (size_t)l * NRETIN * DM, M, NRETIN, DM}; pg8::StaticOrder S; S.init(M, NRETIN, G, bid);
                pg8::EpiRetIn E{Z16, ss_mix, cosT, sinT};

#if EN_G1
 pg8::gemm_phase<pg8::EpiRetIn, pg8::StaticOrder>(lds, gm, S, E);
#endif

                SEAM(ph);
            }
            ++ph;
            if (RUN(ph)) {
#if EN_RS
                const int half = (bid >> 3) & 1, sub = (bid >> 4) * 8 + (bid & 7), nhalf = G >> 1;
                if (half == 0) ret_state_phase<4>(lds, Z16, STATE, (G == 256) ? ((sub & 7) * 16 + (sub >> 3)) : sub, nhalf);
                else { const int t2 = opaque_tid(); conv_all(cs, l == 0 ? CONV_P0_END : CONV_RS0_END, l == 0 ? CONV_RS0_END : CONV_TOTAL, sub * NWAVES + __builtin_amdgcn_readfirstlane(t2 >> 6), nhalf * NWAVES, (LAS unsigned*)(lds + (t2 >> 6) * 8448), t2 & 63); }
#endif
 SEAM(ph); }
            ++ph;
            if (RUN(ph)) {
#if EN_RO
 for (int rep = 0; rep < REP_RO; ++rep) ret_out_phase(lds, Z16, STATE, Yb, G, bid);
#endif
 SEAM(ph); }
            ++ph;
            mixA = Yb; mixB = (const f16*)(ws + WS_W_RETOUT) + (size_t)l * DM * 4096; mixK = 4096; HID = (f16*)(ws + WS_HID_RET);
        } else {
            const int j = l - 2;
            f16* KVb = (f16*)(ws + WS_KV); f16* QA = (f16*)(ws + WS_QATT); f16* OG = (f16*)(ws + WS_OG); f16* O16 = (f16*)(ws + WS_O16);
            if (RUN(ph)) {
                const int nkv = (j == 0) ? NKV : 0;
                pg8::Gemm gm{X16, (j == 0) ? (const f16*)(ws + WS_W_KV) : (const f16*)(ws + WS_W_Q) + (size_t)NATT * DM, M, nkv + NATT, DM}; pg8::StaticOrder S; S.init(M, nkv + NATT, G, bid);
                pg8::EpiPlain E{KVb, NKV, QA, NATT, nkv / 256, 0.08838834764831845f * 1.4426950408889634f, ss_mix};

#if EN_G2
 pg8::gemm_phase<pg8::EpiPlain, pg8::StaticOrder>(lds, gm, S, E);
#endif

                SEAM(ph);
            }
            ++ph;
#pragma clang loop unroll(disable)
            for (int part = 0; part < 2; ++part) {
                if (RUN(ph)) {
#if EN_AT
                    att_phase(part != 0, lds, KVb, QA, OG, LSE, biasT, G, bid, part ? 0 : 512, part ? 512 : 1024, O16);
#endif
                    SEAM(ph); }
                ++ph;
            }
            mixA = O16; mixB = (const f16*)(ws + WS_W_ATTOUT) + (size_t)j * DM * DM; mixK = DM; HID = (f16*)(ws + WS_HID_ATT);
        }
        if (RUN(ph)) {
            pg8::Gemm gm{mixA, mixB, M, DM, mixK}; pg8::StaticOrder S; S.init(M, DM, G, bid);
            pg8::EpiRes E{X16, ss_ffn, XB16};
#if EN_G3
            pg8::gemm_phase<pg8::EpiRes, pg8::StaticOrder, true, true>(lds, gm, S, E);
#endif

            SEAM(ph);
        }
        ++ph;
        if (RUN(ph)) {
            pg8::Gemm gm{XB16, (const f16*)(ws + WS_W_FFNIN) + (size_t)l * 2 * FF * DM, M, 2 * FF, DM}; pg8::StaticOrder S; S.init(M, 2 * FF, G, bid);
            pg8::EpiSwiglu E{HID, ss_ffn};

#if EN_G4
 pg8::gemm_phase<pg8::EpiSwiglu, pg8::StaticOrder, true, true>(lds, gm, S, E);
#endif

            SEAM(ph);
        }
        ++ph;
        if (RUN(ph)) {
            pg8::Gemm gm{HID, (const f16*)(ws + WS_W_FFNOUT) + (size_t)l * DM * FF, M, DM, FF}; pg8::StaticOrder S; S.init(M, DM, G, bid);
            pg8::EpiRes E{X16, ss_next, nullptr};
#if EN_G5
            pg8::gemm_phase<pg8::EpiRes, pg8::StaticOrder, true, true>(lds, gm, S, E);
#endif

            SEAM(ph);
        }
        ++ph;
    }
    if (RUN(ph)) {
        const bool bad = (MK_N_LAUNCHES == 1) && (__hip_atomic_load(ctl + CW_BAR + XB_TMO, RLX_AGENT) != 0u);
        const int tid = opaque_tid(), lane = tid & 63, wave = __builtin_amdgcn_readfirstlane(tid >> 6);
        const float* ssf = ss + (size_t)8 * M; const int gw = vcu * NWAVES + wave, NGW = G * NWAVES;
        for (int m = gw; m < M; m += NGW) {
            const float rs = bad ? __builtin_nanf("") : __builtin_amdgcn_rsqf(ssf[m] * (1.0f / DM) + NORM_EPS);
            const u32x2* xr = (const u32x2*)(X16 + (size_t)m * DM) + lane; f32x4* orow = (f32x4*)(xres + (size_t)m * DM) + lane; const f32x4* gr = (const f32x4*)g_final + lane;
#pragma unroll
            for (int j = 0; j < 8; ++j) { const f16x4 hv = __builtin_bit_cast(f16x4, xr[64 * j]); orow[64 * j] = (f32x4){(float)hv[0], (float)hv[1], (float)hv[2], (float)hv[3]} * rs * gr[64 * j]; }
        }
    }
#undef RUN
#undef SEAM
}

extern "C" void kernel_launch(void* const* d_in, const int* in_sizes, int n_in, void* d_out, int out_size, void* d_ws, size_t ws_size, hipStream_t stream) {
    static int grid = 0;
    if (grid == 0) {
        if (n_in != 13 || in_sizes[0] != M * DM || out_size != M * DM || ws_size < WS_END) {
            fprintf(stderr, "kernel_launch: unexpected shapes (n_in %d, in0 %d, out %d, ws %zu < %zu); nothing launched\n", n_in, n_in > 0 ? in_sizes[0] : -1, out_size, ws_size, (size_t)WS_END); grid = -1; return; }
        int dev = 0, cus = 0, per_cu = 0;
        if (hipGetDevice(&dev) != hipSuccess || hipDeviceGetAttribute(&cus, hipDeviceAttributeMultiprocessorCount, dev) != hipSuccess) { grid = -1; return; }
        if (hipFuncSetAttribute((const void*)yoco_fwd, hipFuncAttributeMaxDynamicSharedMemorySize, LDS_BYTES) != hipSuccess) { fprintf(stderr, "kernel_launch: hipFuncSetAttribute failed\n"); grid = -1; return; }
        if (hipOccupancyMaxActiveBlocksPerMultiprocessor(&per_cu, (const void*)yoco_fwd, NWAVES * 64, LDS_BYTES) != hipSuccess || per_cu < 1)
            fprintf(stderr, "kernel_launch: note: occupancy query reports %d workgroups per CU\n", per_cu);
        (void)hipGetLastError();
        grid = cus;
    }
    if (grid < 0) return;
    if (hipMemsetAsync((char*)d_ws + WS_CTL, 0, CTL_ZERO_BYTES, stream) != hipSuccess) { fprintf(stderr, "kernel_launch: memset failed\n"); return; }
    Args a{};
    for (int i = 0; i < 13; ++i) a.in[i] = (const float*)d_in[i];
    a.out = (float*)d_out; a.ws = (unsigned char*)d_ws;
    if (MK_N_LAUNCHES == 1) {
        a.ph_lo = 0; a.ph_hi = N_PHASES;
        hipLaunchKernelGGL(yoco_fwd, dim3(grid), dim3(NWAVES * 64), LDS_BYTES, stream, a);
    } else {
        for (int k = 0; k < N_PHASES; ++k) { a.ph_lo = k; a.ph_hi = k + 1; hipLaunchKernelGGL(yoco_fwd, dim3(grid), dim3(NWAVES * 64), LDS_BYTES, stream, a); }
    }
    const hipError_t le = hipPeekAtLastError();
    if (le != hipSuccess) fprintf(stderr, "kernel_launch: launch failed: %s\n", hipGetErrorName(le));
}
```

```cpp
#include <hip/hip_runtime.h>
#include <cstdio>
#include <cstdint>
#include <cmath>

#ifndef MK_N_LAUNCHES
#define MK_N_LAUNCHES 1
#endif


#ifndef REP_P0
#define REP_P0 1
#endif
#ifndef REP_RS
#define REP_RS 1
#endif
#ifndef REP_RO
#define REP_RO 1
#endif
#ifndef REP_AT
#define REP_AT 1
#endif
#ifndef REP_MG
#define REP_MG 1
#endif
#ifndef EN_ALL
#define EN_ALL 1
#endif
#ifndef EN_P0
#define EN_P0 EN_ALL
#endif
#ifndef EN_G1
#define EN_G1 EN_ALL
#endif
#ifndef EN_G2
#define EN_G2 EN_ALL
#endif
#ifndef EN_G3
#define EN_G3 EN_ALL
#endif
#ifndef EN_G4
#define EN_G4 EN_ALL
#endif
#ifndef EN_G5
#define EN_G5 EN_ALL
#endif
#ifndef EN_RS
#define EN_RS EN_ALL
#endif
#ifndef EN_RO
#define EN_RO EN_ALL
#endif
#ifndef EN_AT
#define EN_AT EN_ALL
#endif
#define LAS __attribute__((address_space(3)))
#define GAS __attribute__((address_space(1)))
typedef _Float16 f16;
typedef _Float16 f16x8 __attribute__((ext_vector_type(8)));
typedef _Float16 f16x4 __attribute__((ext_vector_type(4)));
typedef _Float16 f16x2 __attribute__((ext_vector_type(2)));
typedef float f32x4 __attribute__((ext_vector_type(4)));
typedef float f32x2 __attribute__((ext_vector_type(2)));
typedef unsigned u32x4 __attribute__((ext_vector_type(4)));
typedef unsigned u32x2 __attribute__((ext_vector_type(2)));
typedef short v4i16 __attribute__((ext_vector_type(4)));

constexpr int BATCH = 2, SEQ = 8192, DM = 2048, M = BATCH * SEQ;
constexpr int RH = 8, RDK = 256, RDV = 512, RC = 128, NCH = SEQ / RC;
constexpr int NRETIN = 12288;
constexpr int AH = 16, AE = 128, NG = 3, NATT = 6144, NKV = 12288;
constexpr int FF = 5632;
constexpr float NORM_EPS = 1e-6f;

__device__ __forceinline__ int opaque_tid() { int t; asm volatile("v_mov_b32 %0, %1" : "=v"(t) : "v"(threadIdx.x)); return t; }
__device__ __forceinline__ unsigned pk2h(float a, float b) { f16x2 h = {(f16)a, (f16)b}; return __builtin_bit_cast(unsigned, h); }
typedef __bf16 bf16x2_t __attribute__((ext_vector_type(2)));
typedef __bf16 bf16x8_t __attribute__((ext_vector_type(8)));
__device__ __forceinline__ unsigned pk2bf(float a, float b) { f32x2 v = {a, b}; bf16x2_t h = __builtin_convertvector(v, bf16x2_t); return __builtin_bit_cast(unsigned, h); }
__device__ __forceinline__ float silu_f(float z) { return z * __builtin_amdgcn_rcpf(1.0f + __expf(-z)); }

namespace pg8 {
constexpr int BM = 256, BK = 64, HALF = 128, HTB = HALF * BK * 2, STAGE_BYTES = 8 * HTB, NXCD = 8, WGM = 4, WGM_WIDE = 8;
__host__ __device__ __forceinline__ int lds_byte(int r, int c) { const int st = (r >> 4) * 2 + (c >> 5), rr = r & 15, cc = c & 31, ob = rr * 64 + cc * 2; return st * 1024 + (ob ^ (((ob >> 9) & 1) << 5)); }
__host__ __device__ __forceinline__ void stage_rc(int b, int& R, int& C) { const int st = b / 1024, sb = b % 1024, swz = sb ^ (((sb >> 9) & 1) << 5); R = (st >> 1) * 16 + swz / 64; C = (st & 1) * 32 + (swz % 64) / 2; }
__host__ __device__ __forceinline__ int perm32(int rho) { const int n = rho >> 4, i = rho & 15; return 8 * (i >> 2) + 4 * n + (i & 3); }

struct Unit { int pm, pn; };
struct Gemm { const f16* A; const f16* Bt; int M, N, K; };

struct StaticOrder {
    int nM, nN, nwg, G, c, wgm;
    __host__ __device__ void init(int M_, int N_, int G_, int c_) { nM = M_ / BM; nN = N_ / BM; nwg = nM * nN; G = G_; c = c_; wgm = (nN <= 8) ? 4 : WGM_WIDE; }
    __host__ __device__ bool next(int i, Unit& u) const {
        const long L = (long)i * G + c; if (L >= nwg) return false;
        int wgid = (int)L; { const int q = nwg / NXCD, r = nwg % NXCD, xcd = wgid % NXCD, off = wgid / NXCD; wgid = (xcd < r ? xcd * (q + 1) : r * (q + 1) + (xcd - r) * q) + off; }
        const int nig = wgm * nN, gid = wgid / nig, fm = gid * wgm, gsz = (nM - fm) < wgm ? (nM - fm) : wgm;
        u.pm = fm + ((wgid % nig) % gsz); u.pn = (wgid % nig) / gsz; return true;
    }
    __device__ __forceinline__ void a_ready(const Unit&) const {}
    __device__ __forceinline__ void done(const Unit&) const {}
};

template <class Epi, class Sched, bool ALIGN_EPI = true, bool BF16 = false>
__device__ __forceinline__ void gemm_phase(LAS unsigned char* lds, const Gemm g, const Sched& S, const Epi& E) {
    const int tid = opaque_tid(), wid = __builtin_amdgcn_readfirstlane(tid >> 6), lane = tid & 63, wr = wid >> 2, wc = wid & 3, fr = lane & 15, fq = lane >> 4;
    const int K = g.K, nt = K / BK;
    unsigned voffA[2], voffB[2];
#pragma unroll
    for (int i = 0; i < 2; ++i) { int R, C; stage_rc(tid * 16 + i * 8192, R, C); const int Rb = (R & ~31) + perm32(R & 31);
        voffA[i] = (unsigned)(R * K + C) * 2u; voffB[i] = (unsigned)(Rb * K + C) * 2u; }
    const size_t kstep = (size_t)(BK * 2);
    const size_t hstep = (size_t)HALF * K * 2;
    const size_t tstep = 2 * hstep;
    const unsigned ldsw = (unsigned)wid * 1024u;
    const int aoff = lds_byte(wr * 64 + fr, fq * 8), boff = lds_byte(wc * 32 + fr, fq * 8);
#define PG8_SA(b, h) (((b) * 2 + (h)) * HTB)
#define PG8_SB(b, h) ((4 + (b) * 2 + (h)) * HTB)
#define PG8_STAGE(bufoff, gbase, voff) do { _Pragma("unroll") for (int _i = 0; _i < 2; ++_i) \
        __builtin_amdgcn_global_load_lds((const unsigned*)((const char*)(gbase) + (voff)[_i]), (LAS unsigned*)(lds + (bufoff) + ldsw + _i * 8192), 16, 0, 0); } while (0)
#define PG8_LDA(dst, b, h) do { _Pragma("unroll") for (int m = 0; m < 4; ++m) _Pragma("unroll") for (int k = 0; k < 2; ++k) dst[m][k] = *(const LAS f16x8*)(lds + PG8_SA(b, h) + aoff + m * 2048 + k * 1024); } while (0)
#define PG8_LDB(dst, b, h) do { _Pragma("unroll") for (int n = 0; n < 2; ++n) _Pragma("unroll") for (int k = 0; k < 2; ++k) dst[n][k] = *(const LAS f16x8*)(lds + PG8_SB(b, h) + boff + n * 2048 + k * 1024); } while (0)
#define PG8_MMA(ai, bj, At, Bt) do { __builtin_amdgcn_s_setprio(1); _Pragma("unroll") for (int m = 0; m < 4; ++m) _Pragma("unroll") for (int n = 0; n < 2; ++n) _Pragma("unroll") for (int k = 0; k < 2; ++k) \
        acc[ai][bj][m][n] = BF16 ? __builtin_amdgcn_mfma_f32_16x16x32_bf16(__builtin_bit_cast(bf16x8_t, Bt[n][k]), __builtin_bit_cast(bf16x8_t, At[m][k]), acc[ai][bj][m][n], 0, 0, 0) \
                                 : __builtin_amdgcn_mfma_f32_16x16x32_f16(Bt[n][k], At[m][k], acc[ai][bj][m][n], 0, 0, 0); __builtin_amdgcn_s_setprio(0); } while (0)
#define PG8_WAIT_V(n) asm volatile("s_waitcnt vmcnt(" #n ")" ::: "memory")
#define PG8_WAIT_L(n) asm volatile("s_waitcnt lgkmcnt(" #n ")" ::: "memory")
#define PG8_BAR __builtin_amdgcn_s_barrier()
#define PG8_SCHED __builtin_amdgcn_sched_barrier(0)
    Unit cur, nxt; int ui = 0;
    if (!S.next(0, cur)) return;
    f32x4 acc[2][2][4][2];
#pragma unroll
    for (int a = 0; a < 2; ++a)
#pragma unroll
        for (int b = 0; b < 2; ++b)
#pragma unroll
            for (int m = 0; m < 4; ++m)
#pragma unroll
                for (int n = 0; n < 2; ++n) acc[a][b][m][n] = (f32x4){0.f, 0.f, 0.f, 0.f};
    f16x8 At[4][2], B0[2][2], B1[2][2];
    float pref[8];
#pragma unroll
    for (int i = 0; i < 8; ++i) pref[i] = 0.f;
    const char* cA = (const char*)g.A + (size_t)cur.pm * tstep; const char* cB = (const char*)g.Bt + (size_t)cur.pn * tstep;
    S.a_ready(cur);
    PG8_STAGE(PG8_SB(0, 0), cB, voffB); PG8_STAGE(PG8_SB(0, 1), cB + hstep, voffB); PG8_STAGE(PG8_SA(0, 0), cA, voffA); PG8_STAGE(PG8_SA(0, 1), cA + hstep, voffA);
    if (wr == 1) PG8_BAR;
    PG8_WAIT_V(2); PG8_BAR;
    PG8_STAGE(PG8_SB(1, 0), cB + kstep, voffB); PG8_STAGE(PG8_SA(1, 0), cA + kstep, voffA); PG8_STAGE(PG8_SB(1, 1), cB + hstep + kstep, voffB);
    PG8_WAIT_V(6); PG8_BAR;
    for (;;) {
        const bool has_next = S.next(ui + 1, nxt);
        const char* nA = has_next ? (const char*)g.A + (size_t)nxt.pm * tstep : cA; const char* nB = has_next ? (const char*)g.Bt + (size_t)nxt.pn * tstep : cB;
        for (int t = 0; t < nt; t += 2) {
            const bool last = (t == nt - 2);
            const char* a1 = cA + (size_t)(t + 1) * kstep;
            const char* a2 = last ? nA : cA + (size_t)(t + 2) * kstep; const char* b2 = last ? nB : cB + (size_t)(t + 2) * kstep;
            const char* a3 = a2 + kstep; const char* b3 = b2 + kstep;
            if (last && has_next) S.a_ready(nxt);
            if (last) E.pre(cur, wr, fr, pref);
            PG8_LDB(B0, 0, 0); PG8_LDB(B1, 0, 1); PG8_SCHED; PG8_LDA(At, 0, 0); PG8_STAGE(PG8_SA(1, 1), a1 + hstep, voffA);
            PG8_WAIT_V(8); PG8_WAIT_L(0); PG8_BAR; PG8_MMA(0, 0, At, B0); PG8_MMA(0, 1, At, B1); PG8_BAR; PG8_SCHED;
            PG8_LDA(At, 0, 1); PG8_STAGE(PG8_SB(0, 0), b2, voffB); PG8_STAGE(PG8_SB(0, 1), b2 + hstep, voffB); PG8_STAGE(PG8_SA(0, 0), a2, voffA);
            PG8_WAIT_V(8); PG8_WAIT_L(0); PG8_BAR; PG8_MMA(1, 0, At, B0); PG8_MMA(1, 1, At, B1); PG8_BAR; PG8_SCHED;
            PG8_LDB(B0, 1, 0); PG8_LDB(B1, 1, 1); PG8_SCHED; PG8_LDA(At, 1, 0); PG8_STAGE(PG8_SA(0, 1), a2 + hstep, voffA);
            PG8_WAIT_V(8); PG8_WAIT_L(0); PG8_BAR; PG8_MMA(0, 0, At, B0); PG8_MMA(0, 1, At, B1); PG8_BAR; PG8_SCHED;
            PG8_LDA(At, 1, 1); PG8_STAGE(PG8_SB(1, 0), b3, voffB); PG8_STAGE(PG8_SB(1, 1), b3 + hstep, voffB); PG8_STAGE(PG8_SA(1, 0), a3, voffA);
            PG8_WAIT_V(8); PG8_WAIT_L(0); PG8_BAR; PG8_MMA(1, 0, At, B0); PG8_MMA(1, 1, At, B1); PG8_BAR; PG8_SCHED;
        }
        if constexpr (ALIGN_EPI) { if (wr == 0) PG8_BAR; }
        E(acc, cur, wr, wc, fr, fq, pref); S.done(cur);
        if (!has_next) break;
#pragma unroll
        for (int a = 0; a < 2; ++a)
#pragma unroll
            for (int b = 0; b < 2; ++b)
#pragma unroll
                for (int m = 0; m < 4; ++m)
#pragma unroll
                    for (int n = 0; n < 2; ++n) acc[a][b][m][n] = (f32x4){0.f, 0.f, 0.f, 0.f};
        cur = nxt; cA = nA; cB = nB; ++ui;
        if constexpr (ALIGN_EPI) { if (wr == 1) PG8_BAR; }
    }
    PG8_WAIT_V(0);
    if constexpr (!ALIGN_EPI) { if (wr == 0) PG8_BAR; }
    PG8_BAR;
#undef PG8_SA
#undef PG8_SB
#undef PG8_STAGE
#undef PG8_LDA
#undef PG8_LDB
#undef PG8_MMA
#undef PG8_WAIT_V
#undef PG8_WAIT_L
#undef PG8_BAR
#undef PG8_SCHED
}

__device__ __forceinline__ float rstd_v(float sumsq) { return __builtin_amdgcn_rsqf(sumsq * (1.0f / DM) + NORM_EPS); }
__device__ __forceinline__ u32x4 pk8(const f32x4 a, const f32x4 b) { u32x4 w; w.x = pk2h(a[0], a[1]); w.y = pk2h(a[2], a[3]); w.z = pk2h(b[0], b[1]); w.w = pk2h(b[2], b[3]); return w; }

struct EpiRetIn {
    f16* Z; const float* ss; const float* cosT; const float* sinT;
    __device__ __forceinline__ void pre(const Unit& u, int wr, int fr, float (&pref)[8]) const {
        const int row0 = u.pm * BM + wr * 64 + fr;
#pragma unroll
        for (int ai = 0; ai < 2; ++ai)
#pragma unroll
            for (int m = 0; m < 4; ++m) pref[ai * 4 + m] = ss[row0 + ai * HALF + m * 16]; }
    __device__ __forceinline__ void operator()(const f32x4 (&acc)[2][2][4][2], const Unit& u, int wr, int wc, int fr, int fq, const float (&pref)[8]) const {
        const int row0 = u.pm * BM + wr * 64 + fr, colt = u.pn * BM, cl = wc * 32 + 8 * fq;
        if (u.pn < 16) {
            const float ksc = (u.pn >= 8) ? 0.0625f : 1.0f;
#pragma unroll
            for (int ai = 0; ai < 2; ++ai)
#pragma unroll
                for (int m = 0; m < 4; ++m) { const int row = row0 + ai * HALF + m * 16; const float rs = rstd_v(pref[ai * 4 + m]) * ksc; const int pos = row & (SEQ - 1);
                    const f32x4 c0 = *(const f32x4*)(cosT + (size_t)pos * 128 + cl), c1 = *(const f32x4*)(cosT + (size_t)pos * 128 + cl + 4);
                    const f32x4 s0 = *(const f32x4*)(sinT + (size_t)pos * 128 + cl), s1 = *(const f32x4*)(sinT + (size_t)pos * 128 + cl + 4);
                    const f32x4 a0 = acc[ai][0][m][0] * rs, a1 = acc[ai][0][m][1] * rs, b0 = acc[ai][1][m][0] * rs, b1 = acc[ai][1][m][1] * rs;
                    const f32x4 o10 = a0 * c0 - b0 * s0, o11 = a1 * c1 - b1 * s1, o20 = b0 * c0 + a0 * s0, o21 = b1 * c1 + a1 * s1;
                    f16* rp = Z + (size_t)row * NRETIN + colt + cl;
                    *(u32x4*)(rp) = pk8(o10, o11); *(u32x4*)(rp + HALF) = pk8(o20, o21); }
        } else {
            const bool gate = (u.pn >= 32);
#pragma unroll
            for (int ai = 0; ai < 2; ++ai)
#pragma unroll
                for (int m = 0; m < 4; ++m) { const int row = row0 + ai * HALF + m * 16; const float rs = rstd_v(pref[ai * 4 + m]);
                    f16* rp = Z + (size_t)row * NRETIN + colt + cl;
#pragma unroll
                    for (int bj = 0; bj < 2; ++bj) { f32x4 v0 = acc[ai][bj][m][0] * rs, v1 = acc[ai][bj][m][1] * rs;
                        if (gate) {
#pragma unroll
                            for (int j = 0; j < 4; ++j) { v0[j] = silu_f(v0[j]); v1[j] = silu_f(v1[j]); } }
                        *(u32x4*)(rp + bj * HALF) = pk8(v0, v1); } }
        }
    }
};
struct EpiPlain {
    f16* O0; int ld0; f16* O1; int ld1; int split; float sc1; const float* ss;
    __device__ __forceinline__ void pre(const Unit& u, int wr, int fr, float (&pref)[8]) const {
        const int row0 = u.pm * BM + wr * 64 + fr;
#pragma unroll
        for (int ai = 0; ai < 2; ++ai)
#pragma unroll
            for (int m = 0; m < 4; ++m) pref[ai * 4 + m] = ss[row0 + ai * HALF + m * 16]; }
    __device__ __forceinline__ void operator()(const f32x4 (&acc)[2][2][4][2], const Unit& u, int wr, int wc, int fr, int fq, const float (&pref)[8]) const {
        const int row0 = u.pm * BM + wr * 64 + fr, cl = wc * 32 + 8 * fq;
        const bool second = u.pn >= split; f16* O = second ? O1 : O0; const int ld = second ? ld1 : ld0; const int colt = (second ? u.pn - split : u.pn) * BM; const float sc = second ? sc1 : 1.0f;
#pragma unroll
        for (int ai = 0; ai < 2; ++ai)
#pragma unroll
            for (int m = 0; m < 4; ++m) { const int row = row0 + ai * HALF + m * 16; const float rs = rstd_v(pref[ai * 4 + m]) * sc;
                f16* rp = O + (size_t)row * ld + colt + cl;
#pragma unroll
                for (int bj = 0; bj < 2; ++bj) *(u32x4*)(rp + bj * HALF) = pk8(acc[ai][bj][m][0] * rs, acc[ai][bj][m][1] * rs); }
    }
};
struct EpiSwiglu {
    f16* Hd; const float* ss;
    __device__ __forceinline__ void pre(const Unit& u, int wr, int fr, float (&pref)[8]) const {
        const int row0 = u.pm * BM + wr * 64 + fr;
#pragma unroll
        for (int ai = 0; ai < 2; ++ai)
#pragma unroll
            for (int m = 0; m < 4; ++m) pref[ai * 4 + m] = ss[row0 + ai * HALF + m * 16]; }
    __device__ __forceinline__ void operator()(const f32x4 (&acc)[2][2][4][2], const Unit& u, int wr, int wc, int fr, int fq, const float (&pref)[8]) const {
        const int row0 = u.pm * BM + wr * 64 + fr, cl = wc * 32 + 8 * fq;
#pragma unroll
        for (int ai = 0; ai < 2; ++ai)
#pragma unroll
            for (int m = 0; m < 4; ++m) { const int row = row0 + ai * HALF + m * 16; const float rs = rstd_v(pref[ai * 4 + m]);
                f32x4 h0, h1;
#pragma unroll
                for (int j = 0; j < 4; ++j) { h0[j] = silu_f(acc[ai][0][m][0][j] * rs) * (acc[ai][1][m][0][j] * rs); h1[j] = silu_f(acc[ai][0][m][1][j] * rs) * (acc[ai][1][m][1][j] * rs); }
                u32x4 hw; hw.x = pk2bf(h0[0], h0[1]); hw.y = pk2bf(h0[2], h0[3]); hw.z = pk2bf(h1[0], h1[1]); hw.w = pk2bf(h1[2], h1[3]);
                *(u32x4*)(Hd + (size_t)row * FF + u.pn * HALF + cl) = hw; }
    }
};
struct EpiRes {
    f16* x16; float* ssn; f16* xb;
    __device__ __forceinline__ void pre(const Unit&, int, int, float (&)[8]) const {}
    __device__ __forceinline__ void operator()(const f32x4 (&acc)[2][2][4][2], const Unit& u, int wr, int wc, int fr, int fq, const float (&pref)[8]) const {
        const int row0 = u.pm * BM + wr * 64 + fr, col0 = u.pn * BM + wc * 32 + 8 * fq;
        f16x8 old[2][4][2];
        float sqv[2][4];
#pragma unroll
        for (int ai = 0; ai < 2; ++ai)
#pragma unroll
            for (int m = 0; m < 4; ++m) { const size_t off = (size_t)(row0 + ai * HALF + m * 16) * DM + col0;
                old[ai][m][0] = *(const f16x8*)(x16 + off); old[ai][m][1] = *(const f16x8*)(x16 + off + HALF); }
#pragma unroll
        for (int ai = 0; ai < 2; ++ai)
#pragma unroll
            for (int m = 0; m < 4; ++m) { const int row = row0 + ai * HALF + m * 16; const size_t off = (size_t)row * DM + col0; float sq = 0.f;
#pragma unroll
                for (int bj = 0; bj < 2; ++bj) { const f16x8 ov = old[ai][m][bj];
                    const f32x4 x0 = (f32x4){(float)ov[0], (float)ov[1], (float)ov[2], (float)ov[3]} + acc[ai][bj][m][0], x1 = (f32x4){(float)ov[4], (float)ov[5], (float)ov[6], (float)ov[7]} + acc[ai][bj][m][1];
                    *(u32x4*)(x16 + off + bj * HALF) = pk8(x0, x1);
                    if (xb) { u32x4 hw; hw.x = pk2bf(x0[0], x0[1]); hw.y = pk2bf(x0[2], x0[3]); hw.z = pk2bf(x1[0], x1[1]); hw.w = pk2bf(x1[2], x1[3]); *(u32x4*)(xb + off + bj * HALF) = hw; }
                    sq += (x0[0] * x0[0] + x0[1] * x0[1]) + (x0[2] * x0[2] + x0[3] * x0[3]) + (x1[0] * x1[0] + x1[1] * x1[1]) + (x1[2] * x1[2] + x1[3] * x1[3]); }
                sq += __shfl_xor(sq, 16); sq += __shfl_xor(sq, 32);
                sqv[ai][m] = sq; }
#pragma unroll
        for (int ai = 0; ai < 2; ++ai) { const float v = (fq == 0) ? sqv[ai][0] : (fq == 1) ? sqv[ai][1] : (fq == 2) ? sqv[ai][2] : sqv[ai][3];
            __hip_atomic_fetch_add(ssn + (row0 + ai * HALF + 16 * fq), v, __ATOMIC_RELAXED, __HIP_MEMORY_SCOPE_AGENT); }
    }
};
}

constexpr size_t MiB = 1u << 20;
constexpr size_t WS_CTL = 0, CTL_ZERO_BYTES = 2 * MiB;
constexpr int CW_TMO = 0, CW_BAR = 4096;
constexpr size_t CTL_SS = 65536;
constexpr size_t WS_COS = 2 * MiB, WS_SIN = 6 * MiB, WS_BIAS = 10 * MiB, WS_LSE = 11 * MiB;
constexpr size_t WS_W_RETIN = 16 * MiB, WS_W_RETOUT = 112 * MiB, WS_W_KV = 144 * MiB, WS_W_Q = 192 * MiB, WS_W_ATTOUT = 240 * MiB, WS_W_FFNIN = 256 * MiB, WS_W_FFNOUT = 432 * MiB;
constexpr size_t WS_X16 = 520 * MiB;
constexpr size_t WS_Z16 = 584 * MiB, WS_STATE = 968 * MiB, WS_Y = 1224 * MiB, WS_HID_RET = 584 * MiB;
constexpr size_t WS_KV = 584 * MiB, WS_QATT = 968 * MiB, WS_OG = 1160 * MiB, WS_O16 = 1160 * MiB, WS_HID_ATT = 1160 * MiB;
constexpr size_t WS_XB16 = 1032 * MiB;
constexpr size_t WS_END = 1352 * MiB;
constexpr int BIAS_PITCH = 132;

constexpr int RING_BYTES = 131072, LDS_BYTES = 147456, LDSCTL_OFF = LDS_BYTES - 512, MISC_OFF = LDSCTL_OFF + 320, NWAVES = 8;

#define RLX_AGENT __ATOMIC_RELAXED, __HIP_MEMORY_SCOPE_AGENT
#define LDS_WAIT() asm volatile("s_waitcnt lgkmcnt(0)" ::: "memory")
#define VM_WAIT() asm volatile("s_waitcnt vmcnt(0)" ::: "memory")

#define XB_TMO      128
#define XB_XCNT(j)  (256  + 64 * (j))
#define XB_XSUB(j)  (1280 + 64 * (j))
#define XB_XGEN(j)  (2304 + 64 * (j))
#define XB_TOP      3328
#define XB_TOPGEN   3392
#define XCD_BAR_WORDS 3456
#define XB_SPIN_CAP (1u << 18)
__device__ __forceinline__ unsigned xb_ld(unsigned* p)              { return __hip_atomic_load(p, __ATOMIC_RELAXED, __HIP_MEMORY_SCOPE_AGENT); }
__device__ __forceinline__ unsigned xb_add(unsigned* p, unsigned v) { return __hip_atomic_fetch_add(p, v, __ATOMIC_RELAXED, __HIP_MEMORY_SCOPE_AGENT); }
__device__ __forceinline__ unsigned xb_xcc_id() { return (unsigned)__builtin_amdgcn_s_getreg((3 << 11) | 20) & 0xFu; }
#define XB_SPIN(cond, bar) do { unsigned _sp = 0; while (cond) { __builtin_amdgcn_s_sleep(1); \
    if ((++_sp & 255u) == 0u) { if (xb_ld(&(bar)[XB_TMO])) break; if (_sp > XB_SPIN_CAP) { atomicAdd(&(bar)[XB_TMO], 1u); break; } } } } while (0)
struct XcdBarrier { unsigned* bar; unsigned x; volatile LAS unsigned* st; };
__device__ __forceinline__ XcdBarrier xcd_barrier_post(unsigned* bar, volatile LAS unsigned* st) {
    XcdBarrier b; b.bar = bar; b.x = xb_xcc_id(); b.st = st;
    if (threadIdx.x == 0) (void)xb_add(&bar[XB_XCNT(b.x)], 1u);
    return b;
}
__device__ __forceinline__ void xcd_barrier_complete(unsigned* bar, unsigned x, unsigned& nloc, unsigned& nx) {
    const unsigned G = gridDim.x * gridDim.y * gridDim.z;
    unsigned sum, cnt, mine, sp = 0u;
    for (;;) {
        sum = 0u; cnt = 0u; mine = 0u;
#pragma unroll
        for (unsigned j = 0; j < 16; ++j) { const unsigned c = xb_ld(&bar[XB_XCNT(j)]); sum += c; cnt += (c > 0u) ? 1u : 0u; mine = (j == x) ? c : mine; }
        if (sum == G) break;
        __builtin_amdgcn_s_sleep(1);
        if ((++sp & 255u) == 0u) { if (xb_ld(&bar[XB_TMO])) break; if (sp > XB_SPIN_CAP) { atomicAdd(&bar[XB_TMO], 1u); break; } }
    }
    nloc = mine > 0u ? mine : 1u; nx = cnt > 0u ? cnt : 1u;
}
__device__ __forceinline__ void xcd_barrier(const XcdBarrier& b) {
    asm volatile("s_waitcnt vmcnt(0)" ::: "memory");
    __syncthreads();
    if (threadIdx.x == 0) {
        unsigned* bar = b.bar;
        __builtin_amdgcn_s_waitcnt(0);
        unsigned nloc = b.st[0], nx = b.st[1];
        if (nloc == 0u) { xcd_barrier_complete(bar, b.x, nloc, nx); b.st[0] = nloc; b.st[1] = nx; }
        const unsigned old = xb_add(&bar[XB_XSUB(b.x)], 1u);
        const unsigned gen = old / nloc;
        if (old + 1u == (gen + 1u) * nloc) {
            __builtin_amdgcn_fence(__ATOMIC_RELEASE, "agent");
            asm volatile("s_waitcnt vmcnt(0)" ::: "memory");
            const unsigned og = xb_add(&bar[XB_TOP], 1u);
            const unsigned tg = og / nx;
            if (og + 1u == (tg + 1u) * nx) xb_add(&bar[XB_TOPGEN], 1u);
            else XB_SPIN(xb_ld(&bar[XB_TOPGEN]) == tg, bar);
            __builtin_amdgcn_fence(__ATOMIC_ACQUIRE, "agent");
            xb_add(&bar[XB_XGEN(b.x)], 1u);
            asm volatile("s_waitcnt vmcnt(0)" ::: "memory");
        } else {
            XB_SPIN(xb_ld(&bar[XB_XGEN(b.x)]) == gen, bar);
            __builtin_amdgcn_fence(__ATOMIC_ACQUIRE, "agent");
            asm volatile("s_waitcnt vmcnt(0)" ::: "memory");
        }
    }
    __syncthreads();
}

__device__ __forceinline__ float wave_sum(float v) {
#pragma unroll
    for (int o = 1; o < 64; o <<= 1) v += __shfl_xor(v, o);
    return v;
}
constexpr int TP = 272, TILE_B = 128 * TP;
__device__ __forceinline__ void tile_load(u32x4 (&r)[4], const f16* src, unsigned stride_bytes, int tid) {
    const unsigned vo = (unsigned)(tid >> 4) * stride_bytes + (unsigned)(tid & 15) * 16u;
#pragma unroll
    for (int i = 0; i < 4; ++i) r[i] = *(const u32x4*)(((const char*)src + (size_t)i * 32u * stride_bytes) + vo);
}
template <int P = TP>
__device__ __forceinline__ void tile_store(LAS unsigned char* buf, const u32x4 (&r)[4], int tid) {
    LAS unsigned char* p = buf + (tid >> 4) * P + (tid & 15) * 16;
#pragma unroll
    for (int i = 0; i < 4; ++i) *(LAS u32x4*)(p + i * 32 * P) = r[i];
}
__device__ __forceinline__ f16x8 frag_row(const LAS unsigned char* buf, int rb, int ks, int li, int g) { return *(const LAS f16x8*)(buf + (li * TP + g * 16) + (rb * 16 * TP + ks * 64)); }
template <bool PERMK, int P = TP>
__device__ __forceinline__ f16x8 frag_tr(const LAS unsigned char* buf, int kbase, int cb, int li, int g) {
    const int q = li >> 2, p = li & 3;
    const LAS unsigned char* a0 = buf + ((PERMK ? (4 * g + q) : (8 * g + q)) * P + 8 * p) + (kbase * P + 32 * cb);
    const v4i16 lo = __builtin_amdgcn_ds_read_tr16_b64_v4i16((LAS v4i16*)a0);
    const v4i16 hi = __builtin_amdgcn_ds_read_tr16_b64_v4i16((LAS v4i16*)(a0 + (PERMK ? 16 : 4) * P));
    const f16x4 l = __builtin_bit_cast(f16x4, lo), h = __builtin_bit_cast(f16x4, hi);
    return (f16x8){l[0], l[1], l[2], l[3], h[0], h[1], h[2], h[3]};
}
#ifndef STAG_SLEEP
#define STAG_SLEEP 1
#endif
#define STAGGER(w) do { if (STAG_SLEEP > 0 && (w) >= 4) __builtin_amdgcn_s_sleep(STAG_SLEEP); } while (0)
#define LBAR() do { asm volatile("s_waitcnt lgkmcnt(0)" ::: "memory"); __builtin_amdgcn_s_barrier(); asm volatile("" ::: "memory"); } while (0)
__device__ __forceinline__ u32x4 widen2(u32x2 A, u32x2 B) {
    const auto rx = __builtin_amdgcn_permlane16_swap(A.x, B.x, false, false), ry = __builtin_amdgcn_permlane16_swap(A.y, B.y, false, false);
    return (u32x4){rx[0], ry[0], rx[1], ry[1]};
}
__device__ __forceinline__ void unwiden2(u32x4 W, u32x2& A, u32x2& B) {
    const auto rx = __builtin_amdgcn_permlane16_swap(W.x, W.z, false, false), ry = __builtin_amdgcn_permlane16_swap(W.y, W.w, false, false);
    A.x = rx[0]; B.x = rx[1]; A.y = ry[0]; B.y = ry[1];
}
#define MFMA16(a, b, c) __builtin_amdgcn_mfma_f32_16x16x32_f16((a), (b), (c), 0, 0, 0)

constexpr int CONV_TOTAL = 64512, CONV_P0_END = 8192, CONV_RS0_END = 36352;
struct ConvSrc { const float *g_mix, *g_ffn, *w_ret_in, *w_ret_out, *g_kv, *w_kv, *w_att_q, *w_att_out, *w_ffn_in, *w_ffn_out; unsigned char* ws; };
struct CvItem { const float* W; const float* gain; f16* WT; int K, N, mode, bf, k0, n0; };
__device__ __forceinline__ CvItem cv_decode(const ConvSrc& c, int item) {
    CvItem t; int r, l; t.bf = 0;
    if (item < 33280) { l = item / 16640; r = item - l * 16640;
        if (r < 6144)       { t.W = c.w_ret_in + (size_t)l * DM * NRETIN; t.K = DM; t.N = NRETIN; t.gain = c.g_mix + l * DM; t.WT = (f16*)(c.ws + WS_W_RETIN) + (size_t)l * NRETIN * DM; t.mode = 0; }
        else if (r < 8192)  { r -= 6144; t.W = c.w_ret_out + (size_t)l * 4096 * DM; t.K = 4096; t.N = DM; t.gain = nullptr; t.WT = (f16*)(c.ws + WS_W_RETOUT) + (size_t)l * DM * 4096; t.mode = 0; t.bf = 1; }
        else if (r < 13824) { r -= 8192; t.W = c.w_ffn_in + (size_t)l * DM * 2 * FF; t.K = DM; t.N = 2 * FF; t.gain = c.g_ffn + l * DM; t.WT = (f16*)(c.ws + WS_W_FFNIN) + (size_t)l * 2 * FF * DM; t.mode = 1; t.bf = 1; }
        else                { r -= 13824; t.W = c.w_ffn_out + (size_t)l * FF * DM; t.K = FF; t.N = DM; t.gain = nullptr; t.WT = (f16*)(c.ws + WS_W_FFNOUT) + (size_t)l * DM * FF; t.mode = 0; t.bf = 1; }
    } else if (item < 39424) { r = item - 33280; t.W = c.w_kv; t.K = DM; t.N = NKV; t.gain = c.g_kv; t.WT = (f16*)(c.ws + WS_W_KV); t.mode = 0;
    } else { const int i3 = item - 39424; const int j = i3 / 12544; r = i3 - j * 12544; l = 2 + j;
        if (r < 3072)      { t.W = c.w_att_q + (size_t)j * DM * NATT; t.K = DM; t.N = NATT; t.gain = c.g_mix + l * DM; t.WT = (f16*)(c.ws + WS_W_Q) + (size_t)j * NATT * DM; t.mode = 0; }
        else if (r < 4096) { r -= 3072; t.W = c.w_att_out + (size_t)j * DM * DM; t.K = DM; t.N = DM; t.gain = nullptr; t.WT = (f16*)(c.ws + WS_W_ATTOUT) + (size_t)j * DM * DM; t.mode = 0; t.bf = 1; }
        else if (r < 9728) { r -= 4096; t.W = c.w_ffn_in + (size_t)l * DM * 2 * FF; t.K = DM; t.N = 2 * FF; t.gain = c.g_ffn + l * DM; t.WT = (f16*)(c.ws + WS_W_FFNIN) + (size_t)l * 2 * FF * DM; t.mode = 1; t.bf = 1; }
        else               { r -= 9728; t.W = c.w_ffn_out + (size_t)l * FF * DM; t.K = FF; t.N = DM; t.gain = nullptr; t.WT = (f16*)(c.ws + WS_W_FFNOUT) + (size_t)l * DM * FF; t.mode = 0; t.bf = 1; }
    }
    const int nnb = t.N / 64, kb = r / nnb; t.k0 = kb * 64; t.n0 = (r - kb * nnb) * 64;
    return t;
}
__device__ __forceinline__ void cv_load(const CvItem& t, f32x4 (&x)[16], int lane) {
    const float* p = t.W + (size_t)(t.k0 + 16 * (lane >> 4)) * t.N + t.n0 + 4 * (lane & 15);
#pragma unroll
    for (int i = 0; i < 16; ++i) x[i] = *(const f32x4*)(p + (size_t)i * t.N);
}
__device__ __forceinline__ void cv_store(const CvItem& t, f32x4 (&x)[16], LAS unsigned* scr, int lane) {
    const int kq = lane >> 4, nq = lane & 15;
    if (t.gain) { const f32x4* gp = (const f32x4*)(t.gain + t.k0 + 16 * kq);
#pragma unroll
        for (int m = 0; m < 4; ++m) { const f32x4 gq = gp[m]; x[4 * m] = x[4 * m] * gq[0]; x[4 * m + 1] = x[4 * m + 1] * gq[1]; x[4 * m + 2] = x[4 * m + 2] * gq[2]; x[4 * m + 3] = x[4 * m + 3] * gq[3]; } }
#pragma unroll
    for (int j = 0; j < 4; ++j) {
        const int ns = t.n0 + 4 * nq + j; int row = ns;
        if (t.mode == 1) { row = (ns < FF) ? (256 * (ns >> 7) + (ns & 127)) : (256 * ((ns - FF) >> 7) + 128 + ((ns - FF) & 127)); }
        u32x4 lo, hi;
        if (t.bf) { lo = (u32x4){pk2bf(x[0][j], x[1][j]), pk2bf(x[2][j], x[3][j]), pk2bf(x[4][j], x[5][j]), pk2bf(x[6][j], x[7][j])};
                    hi = (u32x4){pk2bf(x[8][j], x[9][j]), pk2bf(x[10][j], x[11][j]), pk2bf(x[12][j], x[13][j]), pk2bf(x[14][j], x[15][j])}; }
        else      { lo = (u32x4){pk2h(x[0][j], x[1][j]), pk2h(x[2][j], x[3][j]), pk2h(x[4][j], x[5][j]), pk2h(x[6][j], x[7][j])};
                    hi = (u32x4){pk2h(x[8][j], x[9][j]), pk2h(x[10][j], x[11][j]), pk2h(x[12][j], x[13][j]), pk2h(x[14][j], x[15][j])}; }
        f16* dst = t.WT + (size_t)row * t.K + t.k0 + 16 * kq;
        *(u32x4*)(dst) = lo; *(u32x4*)(dst + 8) = hi; }
}
__device__ __forceinline__ void conv_all(const ConvSrc c, int lo, int hi, int gw, int NGW, LAS unsigned* scr, int lane) {
    int it = lo + gw;
    if (it >= hi) return;
    f32x4 va[16], vb[16];
    CvItem ca = cv_decode(c, it), cb = ca;
    cv_load(ca, va, lane);
    for (;;) {
        const bool hb = (it + NGW) < hi;
        if (hb) { cb = cv_decode(c, it + NGW); cv_load(cb, vb, lane); }
        cv_store(ca, va, scr, lane);
        if (!hb) break;
        it += NGW;
        const bool ha = (it + NGW) < hi;
        if (ha) { ca = cv_decode(c, it + NGW); cv_load(ca, va, lane); }
        cv_store(cb, vb, scr, lane);
        if (!ha) break;
        it += NGW;
    }
}
__device__ __forceinline__ void sincos_d(double a, double& s, double& c) {
    const double k = __builtin_rint(a * 0.63661977236758134308);
    double r = __builtin_fma(-k, 1.57079632679489655800e+00, a); r = __builtin_fma(-k, 6.12323399573676603587e-17, r);
    const double r2 = r * r;
    double ps = -1.0 / 121645100408832000.0;
    ps = ps * r2 + 1.0 / 355687428096000.0;  ps = ps * r2 - 1.0 / 1307674368000.0; ps = ps * r2 + 1.0 / 6227020800.0; ps = ps * r2 - 1.0 / 39916800.0;
    ps = ps * r2 + 1.0 / 362880.0; ps = ps * r2 - 1.0 / 5040.0; ps = ps * r2 + 1.0 / 120.0; ps = ps * r2 - 1.0 / 6.0; ps = ps * r2 + 1.0;
    const double sn = ps * r;
    double pc = 1.0 / 6402373705728000.0;
    pc = pc * r2 - 1.0 / 20922789888000.0; pc = pc * r2 + 1.0 / 87178291200.0; pc = pc * r2 - 1.0 / 479001600.0; pc = pc * r2 + 1.0 / 3628800.0;
    pc = pc * r2 - 1.0 / 40320.0; pc = pc * r2 + 1.0 / 720.0; pc = pc * r2 - 1.0 / 24.0; pc = pc * r2 + 0.5; const double cs = 1.0 - pc * r2;
    const int q = ((int)k) & 3;
    s = (q == 0) ? sn : (q == 1) ? cs : (q == 2) ? -sn : -cs;
    c = (q == 0) ? cs : (q == 1) ? -sn : (q == 2) ? -cs : sn;
}

template <int NET>
__device__ __forceinline__ void ret_state_phase(LAS unsigned char* lds, const f16* __restrict__ Z, f16* __restrict__ ST, int unit0, int ustride) {
    constexpr int NS = 32 / NET, VP = 32 * NET + 32, NVR = NET / 2, KP = 288, KTB = 128 * KP;
    const int tid = opaque_tid();
    const int lane = tid & 63, w = __builtin_amdgcn_readfirstlane(tid >> 6), li = lane & 15, g = lane >> 4, q = li >> 2, p = li & 3;
    LAS unsigned char* kimg = lds; LAS unsigned char* vimg = lds + 2 * KTB;
    for (int u = unit0; u < BATCH * RH * NS; u += ustride) {
        const int b = u / (RH * NS), h = (u / NS) % RH, es = u % NS;
        const float l2g = log2f(1.0f - exp2f(-5.0f - (float)h)), cdec = exp2f(128.0f * l2g);
        const f16* zb = Z + (size_t)b * SEQ * NRETIN;
        const f16* ksrc = zb + 2048 + h * 256; const f16* vsrc = zb + 4096 + h * 512 + es * (16 * NET);
        f16* stb = ST + (size_t)((b * RH + h) * NCH) * (RDV * RDK) + (size_t)(es * 16 * NET) * RDK;
        const float vscale = exp2f((float)(127 - (tid >> 2)) * l2g);
        const unsigned vo = (unsigned)((tid >> 2) * NRETIN + (tid & 3) * 8 * NVR) * 2u;
        f32x4 R[2][NET];
#pragma unroll
        for (int a = 0; a < 2; ++a)
#pragma unroll
            for (int c2 = 0; c2 < NET; ++c2) R[a][c2] = (f32x4){0.f, 0.f, 0.f, 0.f};
        u32x4 kr[2][2][4], vr[2][NVR];
#define RS_LOAD(set, c) do { const f16* kc = ksrc + (size_t)(c) * RC * NRETIN; tile_load(kr[set][0], kc, NRETIN * 2, tid); tile_load(kr[set][1], kc + 128, NRETIN * 2, tid); \
            _Pragma("unroll") for (int i = 0; i < NVR; ++i) vr[set][i] = *(const u32x4*)((const char*)(vsrc + (size_t)(c) * RC * NRETIN) + vo + 16u * i); } while (0)
#define RS_STEP(set, c) do { \
            LBAR(); \
            tile_store<KP>(kimg, kr[set][0], tid); tile_store<KP>(kimg + KTB, kr[set][1], tid); \
            _Pragma("unroll") for (int i = 0; i < NVR; ++i) { const f16x8 vv = __builtin_bit_cast(f16x8, vr[set][i]); f16x8 o; \
              _Pragma("unroll") for (int j = 0; j < 8; ++j) o[j] = (f16)((float)vv[j] * vscale); \
              *(LAS f16x8*)(vimg + (tid >> 2) * VP + (tid & 3) * 16 * NVR + 16 * i) = o; } \
            LBAR(); STAGGER(w); \
            RS_LOAD(set, ((c) + 2 < NCH) ? (c) + 2 : NCH - 1);        \
            { f16* sp = stb + (size_t)(c) * (RDV * RDK);                  \
                _Pragma("unroll") for (int et = 0; et < NET; ++et) { u32x2 o0, o1; o0.x = pk2h(R[0][et][0], R[0][et][1]); o0.y = pk2h(R[0][et][2], R[0][et][3]); o1.x = pk2h(R[1][et][0], R[1][et][1]); o1.y = pk2h(R[1][et][2], R[1][et][3]); \
                    *(u32x4*)(sp + (size_t)(16 * et + li) * RDK + 32 * w + 16 * (g & 1) + 8 * (g >> 1)) = widen2(o0, o1); } } \
            _Pragma("unroll") for (int dt = 0; dt < 2; ++dt) _Pragma("unroll") for (int et = 0; et < NET; ++et) R[dt][et] = R[dt][et] * cdec; \
            const LAS unsigned char* kt = kimg + (w >> 2) * KTB; \
            _Pragma("unroll") for (int ks = 0; ks < 4; ++ks) { \
                f16x8 bf[NET]; \
                _Pragma("unroll") for (int et = 0; et < NET; ++et) { \
                    const LAS unsigned char* a0 = vimg + (32 * ks + 4 * g + q) * VP + 32 * et + 8 * p; \
                    const v4i16 lo = __builtin_amdgcn_ds_read_tr16_b64_v4i16((LAS v4i16*)a0), hi = __builtin_amdgcn_ds_read_tr16_b64_v4i16((LAS v4i16*)(a0 + 16 * VP)); \
                    const f16x4 l = __builtin_bit_cast(f16x4, lo), hh = __builtin_bit_cast(f16x4, hi); \
                    bf[et] = (f16x8){l[0], l[1], l[2], l[3], hh[0], hh[1], hh[2], hh[3]}; } \
                _Pragma("unroll") for (int dt = 0; dt < 2; ++dt) { const f16x8 af = frag_tr<true, KP>(kt, 32 * ks, 2 * (w & 3) + dt, li, g); \
                    _Pragma("unroll") for (int et = 0; et < NET; ++et) R[dt][et] = MFMA16(af, bf[et], R[dt][et]); } } \
        } while (0)
        RS_LOAD(0, 0); RS_LOAD(1, 1);
        RS_STEP(0, 0); RS_STEP(1, 1);
        for (int c = 2; c < NCH; c += 2) { RS_STEP(0, c); RS_STEP(1, c + 1); }
#undef RS_LOAD
#undef RS_STEP
        LBAR();
    }
}

struct RoUnit { const f16* zc; const f16* stc; const f16* ksrc; const f16* vsrc; int h; bool hasr; size_t tok0; };
__device__ __forceinline__ RoUnit ro_decode(int u, const f16* Z, const f16* ST) {
    RoUnit r; const int b = u >> 9, h = (u >> 6) & 7, c = u & 63;
    r.h = h; r.hasr = c > 0; r.tok0 = (size_t)b * SEQ + (size_t)c * RC; r.zc = Z + r.tok0 * NRETIN;
    r.stc = ST + (size_t)((b * RH + h) * NCH + c) * (RDV * RDK); r.ksrc = r.zc + 2048 + h * 256; r.vsrc = r.zc + 4096 + h * 512;
    return r;
}
__device__ __forceinline__ void ret_out_phase(LAS unsigned char* lds, const f16* __restrict__ Z, const f16* __restrict__ ST, f16* __restrict__ Y, int G, int bid) {
    constexpr int NU = BATCH * RH * NCH;
    if (bid >= NU) return;
    RoUnit cur = ro_decode(bid, Z, ST);
    f16x8 Qf[8];
    u32x4 pre[2][4];
    int tid = opaque_tid(), lane = tid & 63, li = lane & 15, g = lane >> 4;
    const int w = __builtin_amdgcn_readfirstlane(tid >> 6);
    unsigned qo = (unsigned)((16 * w + li) * NRETIN + 8 * g) * 2u;
#define RO_LOADQ(un) do { const char* qb_ = (const char*)((un).zc + (un).h * 256); _Pragma("unroll") for (int ks = 0; ks < 8; ++ks) Qf[ks] = *(const f16x8*)(qb_ + (qo + 64u * ks)); } while (0)
#define RO_LDK(set, un, kd)      tile_load(pre[set], (un).ksrc + (kd) * 128, NRETIN * 2, tid)
#define RO_LDR(set, un, eb, kd)  tile_load(pre[set], (un).stc + (size_t)((eb) * 128) * RDK + (kd) * 128, RDK * 2, tid)
#define RO_LDV(set, un, eb)      tile_load(pre[set], (un).vsrc + (eb) * 128, NRETIN * 2, tid)
    RO_LOADQ(cur); RO_LDK(0, cur, 0); RO_LDK(1, cur, 1);
    for (int u = bid; u < NU; u += G) {
        const bool has_next = (u + G) < NU;
        const RoUnit nxt = ro_decode(has_next ? u + G : u, Z, ST);
        const bool hasr = cur.hasr;
        tid = opaque_tid(); lane = tid & 63; li = lane & 15; g = lane >> 4;
        qo = (unsigned)((16 * w + li) * NRETIN + 8 * g) * 2u;
        LAS unsigned char* parkL = lds + 2 * TILE_B + w * 8192 + lane * 8;
        const float l2g = log2f(1.0f - exp2f(-5.0f - (float)cur.h));
        f16x8 Sf[4];
        {
            f32x4 St[8];
#pragma unroll
            for (int jt = 0; jt < 8; ++jt) St[jt] = (f32x4){0.f, 0.f, 0.f, 0.f};
#pragma unroll
            for (int kd = 0; kd < 2; ++kd) {
                LAS unsigned char* buf = lds + kd * TILE_B;
                tile_store(buf, pre[kd], tid); LBAR(); STAGGER(w);
                if (hasr) RO_LDR(kd, cur, kd, 0); else RO_LDV(kd, cur, kd);
#pragma unroll
                for (int jt = 0; jt < 8; ++jt) if (jt <= w)
#pragma unroll
                    for (int ks = 0; ks < 4; ++ks) { St[jt] = MFMA16(frag_row(buf, jt, ks, li, g), Qf[4 * kd + ks], St[jt]); if (ks == 3) __builtin_amdgcn_sched_barrier(0); }
            }
            const int tq = opaque_tid(), i = 16 * w + (tq & 15), gq = (tq >> 4) & 3;
#pragma unroll
            for (int jt = 0; jt < 8; ++jt)
#pragma unroll
                for (int r = 0; r < 4; ++r) { const int j = 16 * jt + 4 * gq + r; St[jt][r] = (i >= j) ? St[jt][r] * __builtin_amdgcn_exp2f((float)(i - j) * l2g) : 0.f; }
#pragma unroll
            for (int s = 0; s < 4; ++s) Sf[s] = (f16x8){(f16)St[2 * s][0], (f16)St[2 * s][1], (f16)St[2 * s][2], (f16)St[2 * s][3], (f16)St[2 * s + 1][0], (f16)St[2 * s + 1][1], (f16)St[2 * s + 1][2], (f16)St[2 * s + 1][3]};
        }
        const float qd = __builtin_amdgcn_exp2f((float)(16 * w + li + 1) * l2g);
        float sq = 0.f;
        f32x4 acc[16];
#pragma unroll
        for (int hf = 0; hf < 2; ++hf) {
#pragma unroll
            for (int a = 0; a < 16; ++a) acc[a] = (f32x4){0.f, 0.f, 0.f, 0.f};
            if (hasr) {
#pragma unroll
                for (int rr = 0; rr < 4; ++rr) {
                    LAS unsigned char* buf = lds + (rr & 1) * TILE_B;
                    tile_store(buf, pre[rr & 1], tid); LBAR(); STAGGER(w);
                    if (rr < 2) RO_LDR(rr & 1, cur, 2 * hf + (rr & 1), 1); else RO_LDV(rr & 1, cur, 2 * hf + (rr & 1));
                    const int ebl = rr & 1, kd = rr >> 1;
#pragma unroll
                    for (int et = 0; et < 8; ++et)
#pragma unroll
                        for (int ks = 0; ks < 4; ++ks) { acc[8 * ebl + et] = MFMA16(frag_row(buf, et, ks, li, g), Qf[4 * kd + ks], acc[8 * ebl + et]); if (ks == 3) __builtin_amdgcn_sched_barrier(0); }
                }
#pragma unroll
                for (int a = 0; a < 16; ++a) acc[a] = acc[a] * qd;
            }
#pragma unroll
            for (int ebl = 0; ebl < 2; ++ebl) {
                LAS unsigned char* buf = lds + ebl * TILE_B;
                tile_store(buf, pre[ebl], tid); LBAR(); STAGGER(w);
                if (hf == 0) { if (hasr) RO_LDR(ebl, cur, 2 + ebl, 0); else RO_LDV(ebl, cur, 2 + ebl); }
                else if (has_next) RO_LDK(ebl, nxt, ebl);
#pragma unroll
                for (int et = 0; et < 8; ++et)
#pragma unroll
                    for (int s = 0; s < 4; ++s) { if (2 * s <= w) acc[8 * ebl + et] = MFMA16(frag_tr<true>(buf, 32 * s, et, li, g), Sf[s], acc[8 * ebl + et]); if (s == 3) __builtin_amdgcn_sched_barrier(0); }
            }
#pragma unroll
            for (int a = 0; a < 16; ++a) sq += (acc[a][0] * acc[a][0] + acc[a][1] * acc[a][1]) + (acc[a][2] * acc[a][2] + acc[a][3] * acc[a][3]);
            if (hf == 0) {
#pragma unroll
                for (int a = 0; a < 16; ++a) { u32x2 o; o.x = pk2h(acc[a][0], acc[a][1]); o.y = pk2h(acc[a][2], acc[a][3]); *(LAS u32x2*)(parkL + 512 * a) = o; }
            }
        }
        sq += __shfl_xor(sq, 16); sq += __shfl_xor(sq, 32);
        const float rs = __builtin_amdgcn_rsqf(sq * (1.0f / RDV) + NORM_EPS);
        const int t2 = opaque_tid(), li2 = t2 & 15, g2 = (t2 >> 4) & 3;
        const unsigned cw = 16 * (g2 & 1) + 8 * (g2 >> 1);
        const unsigned go = (unsigned)((16 * w + li2) * NRETIN) + cw, yo = (unsigned)((16 * w + li2) * 4096) + cw;
        const f16* gp = (cur.zc + 8192 + cur.h * 512) + go; f16* yp = (Y + cur.tok0 * 4096 + cur.h * 512) + yo;
        u32x4 gw[8];
#pragma unroll
        for (int a = 0; a < 8; ++a) gw[a] = *(const u32x4*)(gp + 32 * a);
#pragma unroll
        for (int a = 0; a < 8; ++a) { u32x2 g0, g1; unwiden2(gw[a], g0, g1); const f16x4 ga = __builtin_bit_cast(f16x4, g0), gb = __builtin_bit_cast(f16x4, g1);
            const f16x4 pa = __builtin_bit_cast(f16x4, *(const LAS u32x2*)(parkL + 512 * (2 * a))), pb = __builtin_bit_cast(f16x4, *(const LAS u32x2*)(parkL + 512 * (2 * a + 1)));
            u32x2 o0, o1; o0.x = pk2bf((float)pa[0] * rs * (float)ga[0], (float)pa[1] * rs * (float)ga[1]); o0.y = pk2bf((float)pa[2] * rs * (float)ga[2], (float)pa[3] * rs * (float)ga[3]);
            o1.x = pk2bf((float)pb[0] * rs * (float)gb[0], (float)pb[1] * rs * (float)gb[1]); o1.y = pk2bf((float)pb[2] * rs * (float)gb[2], (float)pb[3] * rs * (float)gb[3]);
            *(u32x4*)(yp + 32 * a) = widen2(o0, o1); }
#pragma unroll
        for (int a = 0; a < 8; ++a) gw[a] = *(const u32x4*)(gp + 256 + 32 * a);
#pragma unroll
        for (int a = 0; a < 8; ++a) { u32x2 g0, g1; unwiden2(gw[a], g0, g1); const f16x4 ga = __builtin_bit_cast(f16x4, g0), gb = __builtin_bit_cast(f16x4, g1);
            const f32x4 av = acc[2 * a], bv = acc[2 * a + 1];
            u32x2 o0, o1; o0.x = pk2bf(av[0] * rs * (float)ga[0], av[1] * rs * (float)ga[1]); o0.y = pk2bf(av[2] * rs * (float)ga[2], av[3] * rs * (float)ga[3]);
            o1.x = pk2bf(bv[0] * rs * (float)gb[0], bv[1] * rs * (float)gb[1]); o1.y = pk2bf(bv[2] * rs * (float)gb[2], bv[3] * rs * (float)gb[3]);
            *(u32x4*)(yp + 256 + 32 * a) = widen2(o0, o1); }
        __builtin_amdgcn_sched_barrier(0);
        if (has_next) RO_LOADQ(nxt);
        cur = nxt;
    }
#undef RO_LOADQ
#undef RO_LDK
#undef RO_LDR
#undef RO_LDV
    LBAR();
}

constexpr int BIAS_ROW = 160, BIAS_PAD = 16;
struct AttUnit { const f16* k0; const f16* k1; const f16* q; unsigned kstride; int gi, hs, d, lse0; bool hasp, cont; size_t tok0; };
__device__ __forceinline__ AttUnit att_decode(int k, int bid, int G, const f16* KV, const f16* QA) {
    AttUnit a; const int u = (bid + (k >> 2) * G) * 4 + (k & 3);
    const int gi = u >> 11, rem = u & 2047, b = rem >> 10, hs = (rem >> 6) & 15, rb = rem & 63, dsh = 2 * gi, d = 1 << dsh, nb = rb & ((64 >> dsh) - 1), r = rb >> (6 - dsh);
    a.gi = gi; a.hs = hs; a.d = d; a.hasp = nb > 0; a.cont = (k & 3) != 0; a.tok0 = (size_t)b * SEQ + r + (size_t)(nb * 128) * d;
    a.lse0 = ((gi * 16 + hs) * BATCH + b) * SEQ + r * (SEQ >> dsh) + nb * 128;
    a.k1 = KV + a.tok0 * NKV + gi * 2048 + hs * 128; a.k0 = a.k1 - (size_t)128 * d * NKV; a.kstride = (unsigned)d * NKV * 2u;
    a.q = QA + a.tok0 * NATT + gi * 2048 + hs * 128;
    return a;
}
__device__ __forceinline__ void att_phase(const bool MERGE, LAS unsigned char* lds, const f16* __restrict__ KV, const f16* __restrict__ QA, f16* OG, float* LSE,
                                          const float* __restrict__ biasT, int G, int bid0, int run0, int nrun, f16* __restrict__ O16) {
    const int bid = run0 + bid0;
    const int tid = opaque_tid();
    const int lane = tid & 63, w = __builtin_amdgcn_readfirstlane(tid >> 6), li = lane & 15, g = lane >> 4;
    LAS float* biasL = (LAS float*)(lds + 4 * TILE_B);
    const int nk = (bid0 < nrun) ? 4 * ((nrun - 1 - bid0) / G + 1) : 0;
    if (nk == 0) return;
    AttUnit cur = att_decode(0, bid, G, KV, QA);
    u32x4 A[4], B[4]; f16x8 Qn[4]; float bn = 0.f;
    const int bc = tid - BIAS_PAD;
    { const char* qb = (const char*)cur.q; const unsigned qo = (unsigned)((16 * w + li) * cur.d) * (unsigned)(NATT * 2) + 16u * g;
#pragma unroll
      for (int ks = 0; ks < 4; ++ks) Qn[ks] = *(const f16x8*)(qb + (qo + 64u * ks)); }
    if (bc >= 0 && bc <= 128) bn = biasT[(cur.gi * 16 + cur.hs) * BIAS_PITCH + bc];
    __builtin_amdgcn_sched_barrier(0);
    if (cur.hasp) tile_load(A, cur.k0, cur.kstride, tid);
    tile_load(B, cur.k1, cur.kstride, tid);
    int sel = 0;
    for (int k = 0; k < nk; ++k) {
        const bool has_next = (k + 1) < nk;
        const AttUnit nxt = att_decode(has_next ? k + 1 : k, bid, G, KV, QA);
        f16x8 Qf[4];
#pragma unroll
        for (int ks = 0; ks < 4; ++ks) Qf[ks] = Qn[ks];
        const bool hasp = cur.hasp, fresh = !cur.cont;
        if (cur.cont) sel ^= 1;
        LAS unsigned char* bKc = lds + sel * TILE_B; LAS unsigned char* bKp = lds + (sel ^ 1) * TILE_B;
        LAS unsigned char* bVc = lds + (2 + sel) * TILE_B; LAS unsigned char* bVp = lds + (2 + (sel ^ 1)) * TILE_B;
        if (fresh && hasp) tile_store(bKp, A, tid);
        tile_store(bKc, B, tid);
        if (tid < BIAS_ROW) biasL[tid] = bn;
        LBAR(); STAGGER(w);
        if (fresh && hasp) tile_load(A, cur.k0 + NATT, cur.kstride, tid);
        tile_load(B, cur.k1 + NATT, cur.kstride, tid);
        f32x4 St[16];
#pragma unroll
        for (int t = 0; t < 16; ++t) St[t] = (f32x4){0.f, 0.f, 0.f, 0.f};
        if (hasp) {
#pragma unroll
            for (int T = 0; T < 8; ++T) if (T >= w) {
#pragma unroll
                for (int ks = 0; ks < 4; ++ks) St[T] = MFMA16(frag_row(bKp, T, ks, li, g), Qf[ks], St[T]);
                __builtin_amdgcn_sched_barrier(0); }
        }
#pragma unroll
        for (int T = 0; T < 8; ++T) if (T <= w) {
#pragma unroll
            for (int ks = 0; ks < 4; ++ks) St[8 + T] = MFMA16(frag_row(bKc, T, ks, li, g), Qf[ks], St[8 + T]);
            __builtin_amdgcn_sched_barrier(0); }
        const int tq = opaque_tid(), liq = tq & 15, gq = (tq >> 4) & 3;
        const LAS float* bl = biasL + BIAS_PAD + (liq - 4 * gq);
        float mx = -INFINITY;
        if (hasp) {
#pragma unroll
            for (int T = 0; T < 8; ++T) if (T >= w) { const bool diag = (T == w);
#pragma unroll
                for (int rg = 0; rg < 4; ++rg) { float sv = St[T][rg] + bl[128 + 16 * (w - T) - rg]; if (diag && (4 * gq + rg < liq)) sv = -INFINITY; St[T][rg] = sv; mx = fmaxf(mx, sv); } }
        }
#pragma unroll
        for (int T = 0; T < 8; ++T) if (T <= w) { const bool diag = (T == w);
#pragma unroll
            for (int rg = 0; rg < 4; ++rg) { float sv = St[8 + T][rg] + bl[16 * (w - T) - rg]; if (diag && (4 * gq + rg > liq)) sv = -INFINITY; St[8 + T][rg] = sv; mx = fmaxf(mx, sv); } }
        mx = fmaxf(mx, __shfl_xor(mx, 16)); mx = fmaxf(mx, __shfl_xor(mx, 32));
        float den = 0.f;
        if (hasp) {
#pragma unroll
            for (int T = 0; T < 8; ++T) if (T >= w) {
#pragma unroll
                for (int rg = 0; rg < 4; ++rg) { const float pv = __builtin_amdgcn_exp2f(St[T][rg] - mx); St[T][rg] = pv; den += pv; } }
        }
#pragma unroll
        for (int T = 0; T < 8; ++T) if (T <= w) {
#pragma unroll
            for (int rg = 0; rg < 4; ++rg) { const float pv = __builtin_amdgcn_exp2f(St[8 + T][rg] - mx); St[8 + T][rg] = pv; den += pv; } }
        den += __shfl_xor(den, 16); den += __shfl_xor(den, 32);
        f16x8 Pf[8];
#pragma unroll
        for (int s = 0; s < 8; ++s) Pf[s] = (f16x8){(f16)St[2 * s][0], (f16)St[2 * s][1], (f16)St[2 * s][2], (f16)St[2 * s][3], (f16)St[2 * s + 1][0], (f16)St[2 * s + 1][1], (f16)St[2 * s + 1][2], (f16)St[2 * s + 1][3]};
        if (fresh && hasp) tile_store(bVp, A, tid);
        tile_store(bVc, B, tid);
        LBAR(); STAGGER(w);
        if (has_next) {
            const char* qb = (const char*)nxt.q; const unsigned qo = (unsigned)((16 * w + li) * nxt.d) * (unsigned)(NATT * 2) + 16u * g;
#pragma unroll
            for (int ks = 0; ks < 4; ++ks) Qn[ks] = *(const f16x8*)(qb + (qo + 64u * ks));
            if (bc >= 0 && bc <= 128) bn = biasT[(nxt.gi * 16 + nxt.hs) * BIAS_PITCH + bc];
            __builtin_amdgcn_sched_barrier(0);
            if (!nxt.cont && nxt.hasp) tile_load(A, nxt.k0, nxt.kstride, tid);
            tile_load(B, nxt.k1, nxt.kstride, tid);
        }
        u32x4 mo1[4], mo2[4]; float ml1 = 0.f, ml2 = 0.f;
        if (MERGE) {
            const int t = (cur.lse0 & (SEQ - 1)) + 16 * w + liq, hb = cur.lse0 - (cur.lse0 & (SEQ - 1));
            const int r1 = hb + 16 * BATCH * SEQ + (t & 3) * (SEQ >> 2) + (t >> 2), r2 = hb + 32 * BATCH * SEQ + (t & 15) * (SEQ >> 4) + (t >> 4);
            const unsigned cw = 16 * (gq & 1) + 8 * (gq >> 1);
            const f16* p1 = OG + (size_t)r1 * 128 + cw; const f16* p2 = OG + (size_t)r2 * 128 + cw;
#pragma unroll
            for (int j = 0; j < 4; ++j) { mo1[j] = *(const u32x4*)(p1 + 32 * j); mo2[j] = *(const u32x4*)(p2 + 32 * j); }
            ml1 = LSE[r1]; ml2 = LSE[r2];
        }
        f32x4 O[8];
#pragma unroll
        for (int et = 0; et < 8; ++et) O[et] = (f32x4){0.f, 0.f, 0.f, 0.f};
        if (hasp) {
#pragma unroll
            for (int s = 0; s < 4; ++s) if (2 * s + 1 >= w) {
#pragma unroll
                for (int et = 0; et < 8; ++et) O[et] = MFMA16(frag_tr<true>(bVp, 32 * s, et, li, g), Pf[s], O[et]);
                __builtin_amdgcn_sched_barrier(0); }
        }
#pragma unroll
        for (int s = 0; s < 4; ++s) if (2 * s <= w) {
#pragma unroll
            for (int et = 0; et < 8; ++et) O[et] = MFMA16(frag_tr<true>(bVc, 32 * s, et, li, g), Pf[4 + s], O[et]);
            __builtin_amdgcn_sched_barrier(0); }
        const float inv = 1.0f / den;
        if (!MERGE) {
            f16* op = OG + (size_t)(cur.lse0 + 16 * w + liq) * 128 + 16 * (gq & 1) + 8 * (gq >> 1);
#pragma unroll
            for (int et = 0; et < 8; et += 2) { u32x2 o0, o1; o0.x = pk2h(O[et][0] * inv, O[et][1] * inv); o0.y = pk2h(O[et][2] * inv, O[et][3] * inv); o1.x = pk2h(O[et + 1][0] * inv, O[et + 1][1] * inv); o1.y = pk2h(O[et + 1][2] * inv, O[et + 1][3] * inv);
                *(u32x4*)(op + 16 * et) = widen2(o0, o1); }
            if (gq == 0) LSE[cur.lse0 + 16 * w + liq] = (mx + __log2f(den)) * 0.6931471805599453f;
        } else {
            const float l0 = (mx + __log2f(den)) * 0.6931471805599453f, mm = fmaxf(l0, fmaxf(ml1, ml2));
            float w0 = __expf(l0 - mm), w1 = __expf(ml1 - mm), w2 = __expf(ml2 - mm); const float iw = 1.0f / (w0 + w1 + w2); w0 *= iw * inv; w1 *= iw; w2 *= iw;
            f16* op = O16 + (cur.tok0 + (size_t)(16 * w + liq)) * DM + cur.hs * 128 + 16 * (gq & 1) + 8 * (gq >> 1);
#pragma unroll
            for (int et = 0; et < 8; et += 2) { float c[8];
#pragma unroll
                for (int i = 0; i < 4; ++i) { const float fa = O[et][i], fb = O[et + 1][i]; const auto rr = __builtin_amdgcn_permlane16_swap(__builtin_bit_cast(unsigned, fa), __builtin_bit_cast(unsigned, fb), false, false);
                    c[i] = __builtin_bit_cast(float, (unsigned)rr[0]); c[4 + i] = __builtin_bit_cast(float, (unsigned)rr[1]); }
                const f16x8 a1 = __builtin_bit_cast(f16x8, mo1[et >> 1]), a2 = __builtin_bit_cast(f16x8, mo2[et >> 1]);
#pragma unroll
                for (int e = 0; e < 8; ++e) c[e] = w0 * c[e] + w1 * (float)a1[e] + w2 * (float)a2[e];
                u32x4 o; o.x = pk2bf(c[0], c[1]); o.y = pk2bf(c[2], c[3]); o.z = pk2bf(c[4], c[5]); o.w = pk2bf(c[6], c[7]);
                *(u32x4*)(op + 16 * et) = o; }
        }
        cur = nxt;
    }
    LBAR();
}
struct Args { const float* in[13]; float* out; unsigned char* ws; int ph_lo, ph_hi; };
constexpr int N_PHASES = 26;

__global__ void __launch_bounds__(NWAVES * 64, 2) yoco_fwd(Args args) {
    extern __shared__ __attribute__((aligned(16))) unsigned char lds_raw[];
    LAS unsigned char* lds = (LAS unsigned char*)lds_raw;
    volatile LAS unsigned* MISC = (volatile LAS unsigned*)(lds + MISC_OFF);
    const int G = gridDim.x, bid = blockIdx.x;
    const int vcu = (G % 8 == 0) ? (bid % 8) * (G / 8) + bid / 8 : bid;
    unsigned char* ws = args.ws;
    unsigned* ctl = (unsigned*)(ws + WS_CTL);
    const float* x_in = args.in[0]; const float* g_mix = args.in[1]; const float* g_ffn = args.in[2]; const float* w_ret_in = args.in[3]; const float* w_ret_out = args.in[4];
    const float* g_kv = args.in[5]; const float* w_kv = args.in[6]; const float* w_att_q = args.in[7]; const float* w_att_out = args.in[8]; const float* rel_bias = args.in[9];
    const float* w_ffn_in = args.in[10]; const float* w_ffn_out = args.in[11]; const float* g_final = args.in[12];
    const ConvSrc cs{g_mix, g_ffn, w_ret_in, w_ret_out, g_kv, w_kv, w_att_q, w_att_out, w_ffn_in, w_ffn_out, ws};
    float* xres = args.out;
    float* ss = (float*)(ws + WS_CTL + CTL_SS);
    float* cosT = (float*)(ws + WS_COS); float* sinT = (float*)(ws + WS_SIN); float* biasT = (float*)(ws + WS_BIAS); float* LSE = (float*)(ws + WS_LSE);
    f16* X16 = (f16*)(ws + WS_X16); f16* XB16 = (f16*)(ws + WS_XB16);
    for (int u = opaque_tid(); u < (LDS_BYTES - LDSCTL_OFF) / 4; u += NWAVES * 64) ((LAS unsigned*)(lds + LDSCTL_OFF))[u] = 0u;
    __syncthreads();
    XcdBarrier bar; bar.bar = ctl + CW_BAR; bar.x = 0; bar.st = nullptr;
    if (MK_N_LAUNCHES == 1) bar = xcd_barrier_post(ctl + CW_BAR, MISC + 8);
    const int lo = args.ph_lo, hi = args.ph_hi;
    int ph = 0;
#define RUN(k) (lo <= (k) && (k) < hi)
#define SEAM(k) do { if ((k) + 1 < hi) xcd_barrier(bar); } while (0)

    if (RUN(ph)) {
#if EN_P0
        for (int rep = 0; rep < REP_P0; ++rep) {
        const int tid = opaque_tid(), lane = tid & 63, wave = __builtin_amdgcn_readfirstlane(tid >> 6);
        const int gw = vcu * NWAVES + wave, NGW = G * NWAVES;
        LAS unsigned* scr = (LAS unsigned*)(lds + wave * 8448);
        conv_all(cs, 0, CONV_P0_END, gw, NGW, scr, lane);
        for (int m = gw; m < M; m += NGW) {
            const f32x4* xr = (const f32x4*)(x_in + (size_t)m * DM) + lane; f32x4 v[8]; float s = 0.f;
#pragma unroll
            for (int j = 0; j < 8; ++j) { v[j] = xr[64 * j]; s += (v[j][0] * v[j][0] + v[j][1] * v[j][1]) + (v[j][2] * v[j][2] + v[j][3] * v[j][3]); }
            s = wave_sum(s); if (lane == 0) ss[m] = s;
            u32x2* o8 = (u32x2*)(X16 + (size_t)m * DM) + lane;
#pragma unroll
            for (int j = 0; j < 8; ++j) { u32x2 o; o.x = pk2h(v[j][0], v[j][1]); o.y = pk2h(v[j][2], v[j][3]); o8[64 * j] = o; }
        }
        const int gt = vcu * 512 + tid, NGT = G * 512;
        for (int idx = gt; idx < SEQ * 128; idx += NGT) {
            const int pos = idx >> 7, i = idx & 127;
            const float inv = (float)(1.0 / exp2((double)i * (1.0 / 127.0) * 13.287712379549449));
            const float ang = __fmul_rn((float)pos, inv);
            double s, c; sincos_d((double)ang, s, c); cosT[idx] = (float)c; sinT[idx] = (float)s;
        }
        for (int idx = gt; idx < 48 * 129; idx += NGT) {
            const int gh = idx / 129, delta = idx - gh * 129, gi = gh >> 4, n = delta << (2 * gi);
            int bk = n;
            if (n >= 16) { bk = 16 + (int)(log((double)n / 16.0) / log(128.0) * 16.0); bk = bk > 31 ? 31 : bk; }
            biasT[gh * BIAS_PITCH + delta] = rel_bias[bk * 48 + gh] * 1.4426950408889634f;
        }
        __syncthreads();
        }
#endif
        SEAM(ph);
    }
    ++ph;

    for (int l = 0; l < 4; ++l) {
        const float* ss_mix = ss + (size_t)(2 * l) * M; float* ss_ffn = ss + (size_t)(2 * l + 1) * M; float* ss_next = ss + (size_t)(2 * l + 2) * M;
        const f16* mixA; const f16* mixB; int mixK;
        f16* HID;
        if (l < 2) {
            f16* Z16 = (f16*)(ws + WS_Z16); f16* STATE = (f16*)(ws + WS_STATE); f16* Yb = (f16*)(ws + WS_Y);
            if (RUN(ph)) {
                pg8::Gemm gm{X16, (const f16*)(ws + WS_W_RETIN) + (size_t)l * NRETIN * DM, M, NRETIN, DM}; pg8::StaticOrder S; S.init(M, NRETIN, G, bid);
                pg8::EpiRetIn E{Z16, ss_mix, cosT, sinT};

#if EN_G1
 pg8::gemm_phase<pg8::EpiRetIn, pg8::StaticOrder>(lds, gm, S, E);
#endif

                SEAM(ph);
            }
            ++ph;
            if (RUN(ph)) {
#if EN_RS
                const int half = (bid >> 3) & 1, sub = (bid >> 4) * 8 + (bid & 7), nhalf = G >> 1;
                if (half == 0) ret_state_phase<4>(lds, Z16, STATE, (G == 256) ? ((sub & 7) * 16 + (sub >> 3)) : sub, nhalf);
                else { const int t2 = opaque_tid(); conv_all(cs, l == 0 ? CONV_P0_END : CONV_RS0_END, l == 0 ? CONV_RS0_END : CONV_TOTAL, sub * NWAVES + __builtin_amdgcn_readfirstlane(t2 >> 6), nhalf * NWAVES, (LAS unsigned*)(lds + (t2 >> 6) * 8448), t2 & 63); }
#endif
 SEAM(ph); }
            ++ph;
            if (RUN(ph)) {
#if EN_RO
 for (int rep = 0; rep < REP_RO; ++rep) ret_out_phase(lds, Z16, STATE, Yb, G, bid);
#endif
 SEAM(ph); }
            ++ph;
            mixA = Yb; mixB = (const f16*)(ws + WS_W_RETOUT) + (size_t)l * DM * 4096; mixK = 4096; HID = (f16*)(ws + WS_HID_RET);
        } else {
            const int j = l - 2;
            f16* KVb = (f16*)(ws + WS_KV); f16* QA = (f16*)(ws + WS_QATT); f16* OG = (f16*)(ws + WS_OG); f16* O16 = (f16*)(ws + WS_O16);
            if (RUN(ph)) {
                const int nkv = (j == 0) ? NKV : 0;
                pg8::Gemm gm{X16, (j == 0) ? (const f16*)(ws + WS_W_KV) : (const f16*)(ws + WS_W_Q) + (size_t)NATT * DM, M, nkv + NATT, DM}; pg8::StaticOrder S; S.init(M, nkv + NATT, G, bid);
                pg8::EpiPlain E{KVb, NKV, QA, NATT, nkv / 256, 0.08838834764831845f * 1.4426950408889634f, ss_mix};

#if EN_G2
 pg8::gemm_phase<pg8::EpiPlain, pg8::StaticOrder>(lds, gm, S, E);
#endif

                SEAM(ph);
            }
            ++ph;
#pragma clang loop unroll(disable)
            for (int part = 0; part < 2; ++part) {
                if (RUN(ph)) {
#if EN_AT
                    att_phase(part != 0, lds, KVb, QA, OG, LSE, biasT, G, bid, part ? 0 : 512, part ? 512 : 1024, O16);
#endif
                    SEAM(ph); }
                ++ph;
            }
            mixA = O16; mixB = (const f16*)(ws + WS_W_ATTOUT) + (size_t)j * DM * DM; mixK = DM; HID = (f16*)(ws + WS_HID_ATT);
        }
        if (RUN(ph)) {
            pg8::Gemm gm{mixA, mixB, M, DM, mixK}; pg8::StaticOrder S; S.init(M, DM, G, bid);
            pg8::EpiRes E{X16, ss_ffn, XB16};
#if EN_G3
            pg8::gemm_phase<pg8::EpiRes, pg8::StaticOrder, true, true>(lds, gm, S, E);
#endif

            SEAM(ph);
        }
        ++ph;
        if (RUN(ph)) {
            pg8::Gemm gm{XB16, (const f16*)(ws + WS_W_FFNIN) + (size_t)l * 2 * FF * DM, M, 2 * FF, DM}; pg8::StaticOrder S; S.init(M, 2 * FF, G, bid);
            pg8::EpiSwiglu E{HID, ss_ffn};

#if EN_G4
 pg8::gemm_phase<pg8::EpiSwiglu, pg8::StaticOrder, true, true>(lds, gm, S, E);
#endif

            SEAM(ph);
        }
        ++ph;
        if (RUN(ph)) {
            pg8::Gemm gm{HID, (const f16*)(ws + WS_W_FFNOUT) + (size_t)l * DM * FF, M, DM, FF}; pg8::StaticOrder S; S.init(M, DM, G, bid);
            pg8::EpiRes E{X16, ss_next, nullptr};
#if EN_G5
            pg8::gemm_phase<pg8::EpiRes, pg8::StaticOrder, true, true>(lds, gm, S, E);
#endif

            SEAM(ph);
        }
        ++ph;
    }
    if (RUN(ph)) {
        const bool bad = (MK_N_LAUNCHES == 1) && (__hip_atomic_load(ctl + CW_BAR + XB_TMO, RLX_AGENT) != 0u);
        const int tid = opaque_tid(), lane = tid & 63, wave = __builtin_amdgcn_readfirstlane(tid >> 6);
        const float* ssf = ss + (size_t)8 * M; const int gw = vcu * NWAVES + wave, NGW = G * NWAVES;
        for (int m = gw; m < M; m += NGW) {
            const float rs = bad ? __builtin_nanf("") : __builtin_amdgcn_rsqf(ssf[m] * (1.0f / DM) + NORM_EPS);
            const u32x2* xr = (const u32x2*)(X16 + (size_t)m * DM) + lane; f32x4* orow = (f32x4*)(xres + (size_t)m * DM) + lane; const f32x4* gr = (const f32x4*)g_final + lane;
#pragma unroll
            for (int j = 0; j < 8; ++j) { const f16x4 hv = __builtin_bit_cast(f16x4, xr[64 * j]); orow[64 * j] = (f32x4){(float)hv[0], (float)hv[1], (float)hv[2], (float)hv[3]} * rs * gr[64 * j]; }
        }
    }
#undef RUN
#undef SEAM
}

extern "C" void kernel_launch(void* const* d_in, const int* in_sizes, int n_in, void* d_out, int out_size, void* d_ws, size_t ws_size, hipStream_t stream) {
    static int grid = 0;
    if (grid == 0) {
        if (n_in != 13 || in_sizes[0] != M * DM || out_size != M * DM || ws_size < WS_END) {
            fprintf(stderr, "kernel_launch: unexpected shapes (n_in %d, in0 %d, out %d, ws %zu < %zu); nothing launched\n", n_in, n_in > 0 ? in_sizes[0] : -1, out_size, ws_size, (size_t)WS_END); grid = -1; return; }
        int dev = 0, cus = 0, per_cu = 0;
        if (hipGetDevice(&dev) != hipSuccess || hipDeviceGetAttribute(&cus, hipDeviceAttributeMultiprocessorCount, dev) != hipSuccess) { grid = -1; return; }
        if (hipFuncSetAttribute((const void*)yoco_fwd, hipFuncAttributeMaxDynamicSharedMemorySize, LDS_BYTES) != hipSuccess) { fprintf(stderr, "kernel_launch: hipFuncSetAttribute failed\n"); grid = -1; return; }
        if (hipOccupancyMaxActiveBlocksPerMultiprocessor(&per_cu, (const void*)yoco_fwd, NWAVES * 64, LDS_BYTES) != hipSuccess || per_cu < 1)
            fprintf(stderr, "kernel_launch: note: occupancy query reports %d workgroups per CU\n", per_cu);
        (void)hipGetLastError();
        grid = cus;
    }
    if (grid < 0) return;
    if (hipMemsetAsync((char*)d_ws + WS_CTL, 0, CTL_ZERO_BYTES, stream) != hipSuccess) { fprintf(stderr, "kernel_launch: memset failed\n"); return; }
    Args a{};
    for (int i = 0; i < 13; ++i) a.in[i] = (const float*)d_in[i];
    a.out = (float*)d_out; a.ws = (unsigned char*)d_ws;
    if (MK_N_LAUNCHES == 1) {
        a.ph_lo = 0; a.ph_hi = N_PHASES;
        hipLaunchKernelGGL(yoco_fwd, dim3(grid), dim3(NWAVES * 64), LDS_BYTES, stream, a);
    } else {
        for (int k = 0; k < N_PHASES; ++k) { a.ph_lo = k; a.ph_hi = k + 1; hipLaunchKernelGGL(yoco_fwd, dim3(grid), dim3(NWAVES * 64), LDS_BYTES, stream, a); }
    }
    const hipError_t le = hipPeekAtLastError();
    if (le != hipSuccess) fprintf(stderr, "kernel_launch: launch failed: %s\n", hipGetErrorName(le));
}
```

```cpp
#include <hip/hip_runtime.h>
#include <cstdio>
#include <cstdint>
#include <cmath>

#ifndef MK_N_LAUNCHES
#define MK_N_LAUNCHES 1
#endif


#ifndef REP_P0
#define REP_P0 1
#endif
#ifndef REP_RS
#define REP_RS 1
#endif
#ifndef REP_RO
#define REP_RO 1
#endif
#ifndef REP_AT
#define REP_AT 1
#endif
#ifndef REP_MG
#define REP_MG 1
#endif
#ifndef EN_ALL
#define EN_ALL 1
#endif
#ifndef EN_P0
#define EN_P0 EN_ALL
#endif
#ifndef EN_G1
#define EN_G1 EN_ALL
#endif
#ifndef EN_G2
#define EN_G2 EN_ALL
#endif
#ifndef EN_G3
#define EN_G3 EN_ALL
#endif
#ifndef EN_G4
#define EN_G4 EN_ALL
#endif
#ifndef EN_G5
#define EN_G5 EN_ALL
#endif
#ifndef EN_RS
#define EN_RS EN_ALL
#endif
#ifndef EN_RO
#define EN_RO EN_ALL
#endif
#ifndef EN_AT
#define EN_AT EN_ALL
#endif
#define LAS __attribute__((address_space(3)))
#define GAS __attribute__((address_space(1)))
typedef _Float16 f16;
typedef _Float16 f16x8 __attribute__((ext_vector_type(8)));
typedef _Float16 f16x4 __attribute__((ext_vector_type(4)));
typedef _Float16 f16x2 __attribute__((ext_vector_type(2)));
typedef float f32x4 __attribute__((ext_vector_type(4)));
typedef float f32x2 __attribute__((ext_vector_type(2)));
typedef unsigned u32x4 __attribute__((ext_vector_type(4)));
typedef unsigned u32x2 __attribute__((ext_vector_type(2)));
typedef short v4i16 __attribute__((ext_vector_type(4)));

constexpr int BATCH = 2, SEQ = 8192, DM = 2048, M = BATCH * SEQ;
constexpr int RH = 8, RDK = 256, RDV = 512, RC = 128, NCH = SEQ / RC;
constexpr int NRETIN = 12288;
constexpr int AH = 16, AE = 128, NG = 3, NATT = 6144, NKV = 12288;
constexpr int FF = 5632;
constexpr float NORM_EPS = 1e-6f;

__device__ __forceinline__ int opaque_tid() { int t; asm volatile("v_mov_b32 %0, %1" : "=v"(t) : "v"(threadIdx.x)); return t; }
__device__ __forceinline__ unsigned pk2h(float a, float b) { f16x2 h = {(f16)a, (f16)b}; return __builtin_bit_cast(unsigned, h); }
typedef __bf16 bf16x2_t __attribute__((ext_vector_type(2)));
typedef __bf16 bf16x8_t __attribute__((ext_vector_type(8)));
__device__ __forceinline__ unsigned pk2bf(float a, float b) { f32x2 v = {a, b}; bf16x2_t h = __builtin_convertvector(v, bf16x2_t); return __builtin_bit_cast(unsigned, h); }
__device__ __forceinline__ float silu_f(float z) { return z * __builtin_amdgcn_rcpf(1.0f + __expf(-z)); }

namespace pg8 {
constexpr int BM = 256, BK = 64, HALF = 128, HTB = HALF * BK * 2, STAGE_BYTES = 8 * HTB, NXCD = 8, WGM = 4, WGM_WIDE = 8;
__host__ __device__ __forceinline__ int lds_byte(int r, int c) { const int st = (r >> 4) * 2 + (c >> 5), rr = r & 15, cc = c & 31, ob = rr * 64 + cc * 2; return st * 1024 + (ob ^ (((ob >> 9) & 1) << 5)); }
__host__ __device__ __forceinline__ void stage_rc(int b, int& R, int& C) { const int st = b / 1024, sb = b % 1024, swz = sb ^ (((sb >> 9) & 1) << 5); R = (st >> 1) * 16 + swz / 64; C = (st & 1) * 32 + (swz % 64) / 2; }
__host__ __device__ __forceinline__ int perm32(int rho) { const int n = rho >> 4, i = rho & 15; return 8 * (i >> 2) + 4 * n + (i & 3); }

struct Unit { int pm, pn; };
struct Gemm { const f16* A; const f16* Bt; int M, N, K; };

struct StaticOrder {
    int nM, nN, nwg, G, c, wgm;
    __host__ __device__ void init(int M_, int N_, int G_, int c_) { nM = M_ / BM; nN = N_ / BM; nwg = nM * nN; G = G_; c = c_; wgm = (nN <= 8) ? 4 : WGM_WIDE; }
    __host__ __device__ bool next(int i, Unit& u) const {
        const long L = (long)i * G + c; if (L >= nwg) return false;
        int wgid = (int)L; { const int q = nwg / NXCD, r = nwg % NXCD, xcd = wgid % NXCD, off = wgid / NXCD; wgid = (xcd < r ? xcd * (q + 1) : r * (q + 1) + (xcd - r) * q) + off; }
        const int nig = wgm * nN, gid = wgid / nig, fm = gid * wgm, gsz = (nM - fm) < wgm ? (nM - fm) : wgm;
        u.pm = fm + ((wgid % nig) % gsz); u.pn = (wgid % nig) / gsz; return true;
    }
    __device__ __forceinline__ void a_ready(const Unit&) const {}
    __device__ __forceinline__ void done(const Unit&) const {}
};

template <class Epi, class Sched, bool ALIGN_EPI = true, bool BF16 = false>
__device__ __forceinline__ void gemm_phase(LAS unsigned char* lds, const Gemm g, const Sched& S, const Epi& E) {
    const int tid = opaque_tid(), wid = __builtin_amdgcn_readfirstlane(tid >> 6), lane = tid & 63, wr = wid >> 2, wc = wid & 3, fr = lane & 15, fq = lane >> 4;
    const int K = g.K, nt = K / BK;
    unsigned voffA[2], voffB[2];
#pragma unroll
    for (int i = 0; i < 2; ++i) { int R, C; stage_rc(tid * 16 + i * 8192, R, C); const int Rb = (R & ~31) + perm32(R & 31);
        voffA[i] = (unsigned)(R * K + C) * 2u; voffB[i] = (unsigned)(Rb * K + C) * 2u; }
    const size_t kstep = (size_t)(BK * 2);
    const size_t hstep = (size_t)HALF * K * 2;
    const size_t tstep = 2 * hstep;
    const unsigned ldsw = (unsigned)wid * 1024u;
    const int aoff = lds_byte(wr * 64 + fr, fq * 8), boff = lds_byte(wc * 32 + fr, fq * 8);
#define PG8_SA(b, h) (((b) * 2 + (h)) * HTB)
#define PG8_SB(b, h) ((4 + (b) * 2 + (h)) * HTB)
#define PG8_STAGE(bufoff, gbase, voff) do { _Pragma("unroll") for (int _i = 0; _i < 2; ++_i) \
        __builtin_amdgcn_global_load_lds((const unsigned*)((const char*)(gbase) + (voff)[_i]), (LAS unsigned*)(lds + (bufoff) + ldsw + _i * 8192), 16, 0, 0); } while (0)
#define PG8_LDA(dst, b, h) do { _Pragma("unroll") for (int m = 0; m < 4; ++m) _Pragma("unroll") for (int k = 0; k < 2; ++k) dst[m][k] = *(const LAS f16x8*)(lds + PG8_SA(b, h) + aoff + m * 2048 + k * 1024); } while (0)
#define PG8_LDB(dst, b, h) do { _Pragma("unroll") for (int n = 0; n < 2; ++n) _Pragma("unroll") for (int k = 0; k < 2; ++k) dst[n][k] = *(const LAS f16x8*)(lds + PG8_SB(b, h) + boff + n * 2048 + k * 1024); } while (0)
#define PG8_MMA(ai, bj, At, Bt) do { __builtin_amdgcn_s_setprio(1); _Pragma("unroll") for (int m = 0; m < 4; ++m) _Pragma("unroll") for (int n = 0; n < 2; ++n) _Pragma("unroll") for (int k = 0; k < 2; ++k) \
        acc[ai][bj][m][n] = BF16 ? __builtin_amdgcn_mfma_f32_16x16x32_bf16(__builtin_bit_cast(bf16x8_t, Bt[n][k]), __builtin_bit_cast(bf16x8_t, At[m][k]), acc[ai][bj][m][n], 0, 0, 0) \
                                 : __builtin_amdgcn_mfma_f32_16x16x32_f16(Bt[n][k], At[m][k], acc[ai][bj][m][n], 0, 0, 0); __builtin_amdgcn_s_setprio(0); } while (0)
#define PG8_WAIT_V(n) asm volatile("s_waitcnt vmcnt(" #n ")" ::: "memory")
#define PG8_WAIT_L(n) asm volatile("s_waitcnt lgkmcnt(" #n ")" ::: "memory")
#define PG8_BAR __builtin_amdgcn_s_barrier()
#define PG8_SCHED __builtin_amdgcn_sched_barrier(0)
    Unit cur, nxt; int ui = 0;
    if (!S.next(0, cur)) return;
    f32x4 acc[2][2][4][2];
#pragma unroll
    for (int a = 0; a < 2; ++a)
#pragma unroll
        for (int b = 0; b < 2; ++b)
#pragma unroll
            for (int m = 0; m < 4; ++m)
#pragma unroll
                for (int n = 0; n < 2; ++n) acc[a][b][m][n] = (f32x4){0.f, 0.f, 0.f, 0.f};
    f16x8 At[4][2], B0[2][2], B1[2][2];
    float pref[8];
#pragma unroll
    for (int i = 0; i < 8; ++i) pref[i] = 0.f;
    const char* cA = (const char*)g.A + (size_t)cur.pm * tstep; const char* cB = (const char*)g.Bt + (size_t)cur.pn * tstep;
    S.a_ready(cur);
    PG8_STAGE(PG8_SB(0, 0), cB, voffB); PG8_STAGE(PG8_SB(0, 1), cB + hstep, voffB); PG8_STAGE(PG8_SA(0, 0), cA, voffA); PG8_STAGE(PG8_SA(0, 1), cA + hstep, voffA);
    if (wr == 1) PG8_BAR;
    PG8_WAIT_V(2); PG8_BAR;
    PG8_STAGE(PG8_SB(1, 0), cB + kstep, voffB); PG8_STAGE(PG8_SA(1, 0), cA + kstep, voffA); PG8_STAGE(PG8_SB(1, 1), cB + hstep + kstep, voffB);
    PG8_WAIT_V(6); PG8_BAR;
    for (;;) {
        const bool has_next = S.next(ui + 1, nxt);
        const char* nA = has_next ? (const char*)g.A + (size_t)nxt.pm * tstep : cA; const char* nB = has_next ? (const char*)g.Bt + (size_t)nxt.pn * tstep : cB;
        for (int t = 0; t < nt; t += 2) {
            const bool last = (t == nt - 2);
            const char* a1 = cA + (size_t)(t + 1) * kstep;
            const char* a2 = last ? nA : cA + (size_t)(t + 2) * kstep; const char* b2 = last ? nB : cB + (size_t)(t + 2) * kstep;
            const char* a3 = a2 + kstep; const char* b3 = b2 + kstep;
            if (last && has_next) S.a_ready(nxt);
            if (last) E.pre(cur, wr, fr, pref);
            PG8_LDB(B0, 0, 0); PG8_LDB(B1, 0, 1); PG8_SCHED; PG8_LDA(At, 0, 0); PG8_STAGE(PG8_SA(1, 1), a1 + hstep, voffA);
            PG8_WAIT_V(8); PG8_WAIT_L(0); PG8_BAR; PG8_MMA(0, 0, At, B0); PG8_MMA(0, 1, At, B1); PG8_BAR; PG8_SCHED;
            PG8_LDA(At, 0, 1); PG8_STAGE(PG8_SB(0, 0), b2, voffB); PG8_STAGE(PG8_SB(0, 1), b2 + hstep, voffB); PG8_STAGE(PG8_SA(0, 0), a2, voffA);
            PG8_WAIT_V(8); PG8_WAIT_L(0); PG8_BAR; PG8_MMA(1, 0, At, B0); PG8_MMA(1, 1, At, B1); PG8_BAR; PG8_SCHED;
            PG8_LDB(B0, 1, 0); PG8_LDB(B1, 1, 1); PG8_SCHED; PG8_LDA(At, 1, 0); PG8_STAGE(PG8_SA(0, 1), a2 + hstep, voffA);
            PG8_WAIT_V(8); PG8_WAIT_L(0); PG8_BAR; PG8_MMA(0, 0, At, B0); PG8_MMA(0, 1, At, B1); PG8_BAR; PG8_SCHED;
            PG8_LDA(At, 1, 1); PG8_STAGE(PG8_SB(1, 0), b3, voffB); PG8_STAGE(PG8_SB(1, 1), b3 + hstep, voffB); PG8_STAGE(PG8_SA(1, 0), a3, voffA);
            PG8_WAIT_V(8); PG8_WAIT_L(0); PG8_BAR; PG8_MMA(1, 0, At, B0); PG8_MMA(1, 1, At, B1); PG8_BAR; PG8_SCHED;
        }
        if constexpr (ALIGN_EPI) { if (wr == 0) PG8_BAR; }
        E(acc, cur, wr, wc, fr, fq, pref); S.done(cur);
        if (!has_next) break;
#pragma unroll
        for (int a = 0; a < 2; ++a)
#pragma unroll
            for (int b = 0; b < 2; ++b)
#pragma unroll
                for (int m = 0; m < 4; ++m)
#pragma unroll
                    for (int n = 0; n < 2; ++n) acc[a][b][m][n] = (f32x4){0.f, 0.f, 0.f, 0.f};
        cur = nxt; cA = nA; cB = nB; ++ui;
        if constexpr (ALIGN_EPI) { if (wr == 1) PG8_BAR; }
    }
    PG8_WAIT_V(0);
    if constexpr (!ALIGN_EPI) { if (wr == 0) PG8_BAR; }
    PG8_BAR;
#undef PG8_SA
#undef PG8_SB
#undef PG8_STAGE
#undef PG8_LDA
#undef PG8_LDB
#undef PG8_MMA
#undef PG8_WAIT_V
#undef PG8_WAIT_L
#undef PG8_BAR
#undef PG8_SCHED
}

__device__ __forceinline__ float rstd_v(float sumsq) { return __builtin_amdgcn_rsqf(sumsq * (1.0f / DM) + NORM_EPS); }
__device__ __forceinline__ u32x4 pk8(const f32x4 a, const f32x4 b) { u32x4 w; w.x = pk2h(a[0], a[1]); w.y = pk2h(a[2], a[3]); w.z = pk2h(b[0], b[1]); w.w = pk2h(b[2], b[3]); return w; }

struct EpiRetIn {
    f16* Z; const float* ss; const float* cosT; const float* sinT;
    __device__ __forceinline__ void pre(const Unit& u, int wr, int fr, float (&pref)[8]) const {
        const int row0 = u.pm * BM + wr * 64 + fr;
#pragma unroll
        for (int ai = 0; ai < 2; ++ai)
#pragma unroll
            for (int m = 0; m < 4; ++m) pref[ai * 4 + m] = ss[row0 + ai * HALF + m * 16]; }
    __device__ __forceinline__ void operator()(const f32x4 (&acc)[2][2][4][2], const Unit& u, int wr, int wc, int fr, int fq, const float (&pref)[8]) const {
        const int row0 = u.pm * BM + wr * 64 + fr, colt = u.pn * BM, cl = wc * 32 + 8 * fq;
        if (u.pn < 16) {
            const float ksc = (u.pn >= 8) ? 0.0625f : 1.0f;
#pragma unroll
            for (int ai = 0; ai < 2; ++ai)
#pragma unroll
                for (int m = 0; m < 4; ++m) { const int row = row0 + ai * HALF + m * 16; const float rs = rstd_v(pref[ai * 4 + m]) * ksc; const int pos = row & (SEQ - 1);
                    const f32x4 c0 = *(const f32x4*)(cosT + (size_t)pos * 128 + cl), c1 = *(const f32x4*)(cosT + (size_t)pos * 128 + cl + 4);
                    const f32x4 s0 = *(const f32x4*)(sinT + (size_t)pos * 128 + cl), s1 = *(const f32x4*)(sinT + (size_t)pos * 128 + cl + 4);
                    const f32x4 a0 = acc[ai][0][m][0] * rs, a1 = acc[ai][0][m][1] * rs, b0 = acc[ai][1][m][0] * rs, b1 = acc[ai][1][m][1] * rs;
                    const f32x4 o10 = a0 * c0 - b0 * s0, o11 = a1 * c1 - b1 * s1, o20 = b0 * c0 + a0 * s0, o21 = b1 * c1 + a1 * s1;
                    f16* rp = Z + (size_t)row * NRETIN + colt + cl;
                    *(u32x4*)(rp) = pk8(o10, o11); *(u32x4*)(rp + HALF) = pk8(o20, o21); }
        } else {
            const bool gate = (u.pn >= 32);
#pragma unroll
            for (int ai = 0; ai < 2; ++ai)
#pragma unroll
                for (int m = 0; m < 4; ++m) { const int row = row0 + ai * HALF + m * 16; const float rs = rstd_v(pref[ai * 4 + m]);
                    f16* rp = Z + (size_t)row * NRETIN + colt + cl;
#pragma unroll
                    for (int bj = 0; bj < 2; ++bj) { f32x4 v0 = acc[ai][bj][m][0] * rs, v1 = acc[ai][bj][m][1] * rs;
                        if (gate) {
#pragma unroll
                            for (int j = 0; j < 4; ++j) { v0[j] = silu_f(v0[j]); v1[j] = silu_f(v1[j]); } }
                        *(u32x4*)(rp + bj * HALF) = pk8(v0, v1); } }
        }
    }
};
struct EpiPlain {
    f16* O0; int ld0; f16* O1; int ld1; int split; float sc1; const float* ss;
    __device__ __forceinline__ void pre(const Unit& u, int wr, int fr, float (&pref)[8]) const {
        const int row0 = u.pm * BM + wr * 64 + fr;
#pragma unroll
        for (int ai = 0; ai < 2; ++ai)
#pragma unroll
            for (int m = 0; m < 4; ++m) pref[ai * 4 + m] = ss[row0 + ai * HALF + m * 16]; }
    __device__ __forceinline__ void operator()(const f32x4 (&acc)[2][2][4][2], const Unit& u, int wr, int wc, int fr, int fq, const float (&pref)[8]) const {
        const int row0 = u.pm * BM + wr * 64 + fr, cl = wc * 32 + 8 * fq;
        const bool second = u.pn >= split; f16* O = second ? O1 : O0; const int ld = second ? ld1 : ld0; const int colt = (second ? u.pn - split : u.pn) * BM; const float sc = second ? sc1 : 1.0f;
#pragma unroll
        for (int ai = 0; ai < 2; ++ai)
#pragma unroll
            for (int m = 0; m < 4; ++m) { const int row = row0 + ai * HALF + m * 16; const float rs = rstd_v(pref[ai * 4 + m]) * sc;
                f16* rp = O + (size_t)row * ld + colt + cl;
#pragma unroll
                for (int bj = 0; bj < 2; ++bj) *(u32x4*)(rp + bj * HALF) = pk8(acc[ai][bj][m][0] * rs, acc[ai][bj][m][1] * rs); }
    }
};
struct EpiSwiglu {
    f16* Hd; const float* ss;
    __device__ __forceinline__ void pre(const Unit& u, int wr, int fr, float (&pref)[8]) const {
        const int row0 = u.pm * BM + wr * 64 + fr;
#pragma unroll
        for (int ai = 0; ai < 2; ++ai)
#pragma unroll
            for (int m = 0; m < 4; ++m) pref[ai * 4 + m] = ss[row0 + ai * HALF + m * 16]; }
    __device__ __forceinline__ void operator()(const f32x4 (&acc)[2][2][4][2], const Unit& u, int wr, int wc, int fr, int fq, const float (&pref)[8]) const {
        const int row0 = u.pm * BM + wr * 64 + fr, cl = wc * 32 + 8 * fq;
#pragma unroll
        for (int ai = 0; ai < 2; ++ai)
#pragma unroll
            for (int m = 0; m < 4; ++m) { const int row = row0 + ai * HALF + m * 16; const float rs = rstd_v(pref[ai * 4 + m]);
                f32x4 h0, h1;
#pragma unroll
                for (int j = 0; j < 4; ++j) { h0[j] = silu_f(acc[ai][0][m][0][j] * rs) * (acc[ai][1][m][0][j] * rs); h1[j] = silu_f(acc[ai][0][m][1][j] * rs) * (acc[ai][1][m][1][j] * rs); }
                u32x4 hw; hw.x = pk2bf(h0[0], h0[1]); hw.y = pk2bf(h0[2], h0[3]); hw.z = pk2bf(h1[0], h1[1]); hw.w = pk2bf(h1[2], h1[3]);
                *(u32x4*)(Hd + (size_t)row * FF + u.pn * HALF + cl) = hw; }
    }
};
struct EpiRes {
    f16* x16; float* ssn; f16* xb;
    __device__ __forceinline__ void pre(const Unit&, int, int, float (&)[8]) const {}
    __device__ __forceinline__ void operator()(const f32x4 (&acc)[2][2][4][2], const Unit& u, int wr, int wc, int fr, int fq, const float (&pref)[8]) const {
        const int row0 = u.pm * BM + wr * 64 + fr, col0 = u.pn * BM + wc * 32 + 8 * fq;
        f16x8 old[2][4][2];
        float sqv[2][4];
#pragma unroll
        for (int ai = 0; ai < 2; ++ai)
#pragma unroll
            for (int m = 0; m < 4; ++m) { const size_t off = (size_t)(row0 + ai * HALF + m * 16) * DM + col0;
                old[ai][m][0] = *(const f16x8*)(x16 + off); old[ai][m][1] = *(const f16x8*)(x16 + off + HALF); }
#pragma unroll
        for (int ai = 0; ai < 2; ++ai)
#pragma unroll
            for (int m = 0; m < 4; ++m) { const int row = row0 + ai * HALF + m * 16; const size_t off = (size_t)row * DM + col0; float sq = 0.f;
#pragma unroll
                for (int bj = 0; bj < 2; ++bj) { const f16x8 ov = old[ai][m][bj];
                    const f32x4 x0 = (f32x4){(float)ov[0], (float)ov[1], (float)ov[2], (float)ov[3]} + acc[ai][bj][m][0], x1 = (f32x4){(float)ov[4], (float)ov[5], (float)ov[6], (float)ov[7]} + acc[ai][bj][m][1];
                    *(u32x4*)(x16 + off + bj * HALF) = pk8(x0, x1);
                    if (xb) { u32x4 hw; hw.x = pk2bf(x0[0], x0[1]); hw.y = pk2bf(x0[2], x0[3]); hw.z = pk2bf(x1[0], x1[1]); hw.w = pk2bf(x1[2], x1[3]); *(u32x4*)(xb + off + bj * HALF) = hw; }
                    sq += (x0[0] * x0[0] + x0[1] * x0[1]) + (x0[2] * x0[2] + x0[3] * x0[3]) + (x1[0] * x1[0] + x1[1] * x1[1]) + (x1[2] * x1[2] + x1[3] * x1[3]); }
                sq += __shfl_xor(sq, 16); sq += __shfl_xor(sq, 32);
                sqv[ai][m] = sq; }
#pragma unroll
        for (int ai = 0; ai < 2; ++ai) { const float v = (fq == 0) ? sqv[ai][0] : (fq == 1) ? sqv[ai][1] : (fq == 2) ? sqv[ai][2] : sqv[ai][3];
            __hip_atomic_fetch_add(ssn + (row0 + ai * HALF + 16 * fq), v, __ATOMIC_RELAXED, __HIP_MEMORY_SCOPE_AGENT); }
    }
};
}

constexpr size_t MiB = 1u << 20;
constexpr size_t WS_CTL = 0, CTL_ZERO_BYTES = 2 * MiB;
constexpr int CW_TMO = 0, CW_BAR = 4096;
constexpr size_t CTL_SS = 65536;
constexpr size_t WS_COS = 2 * MiB, WS_SIN = 6 * MiB, WS_BIAS = 10 * MiB, WS_LSE = 11 * MiB;
constexpr size_t WS_W_RETIN = 16 * MiB, WS_W_RETOUT = 112 * MiB, WS_W_KV = 144 * MiB, WS_W_Q = 192 * MiB, WS_W_ATTOUT = 240 * MiB, WS_W_FFNIN = 256 * MiB, WS_W_FFNOUT = 432 * MiB;
constexpr size_t WS_X16 = 520 * MiB;
constexpr size_t WS_Z16 = 584 * MiB, WS_STATE = 968 * MiB, WS_Y = 1224 * MiB, WS_HID_RET = 584 * MiB;
constexpr size_t WS_KV = 584 * MiB, WS_QATT = 968 * MiB, WS_OG = 1160 * MiB, WS_O16 = 1160 * MiB, WS_HID_ATT = 1160 * MiB;
constexpr size_t WS_XB16 = 1032 * MiB;
constexpr size_t WS_XBA = 16 * MiB;
constexpr size_t WS_END = 1352 * MiB;
constexpr int BIAS_PITCH = 132;

constexpr int RING_BYTES = 131072, LDS_BYTES = 147456, LDSCTL_OFF = LDS_BYTES - 512, MISC_OFF = LDSCTL_OFF + 320, NWAVES = 8;

#define RLX_AGENT __ATOMIC_RELAXED, __HIP_MEMORY_SCOPE_AGENT
#define LDS_WAIT() asm volatile("s_waitcnt lgkmcnt(0)" ::: "memory")
#define VM_WAIT() asm volatile("s_waitcnt vmcnt(0)" ::: "memory")

#define XB_TMO      128
#define XB_XCNT(j)  (256  + 64 * (j))
#define XB_XSUB(j)  (1280 + 64 * (j))
#define XB_XGEN(j)  (2304 + 64 * (j))
#define XB_TOP      3328
#define XB_TOPGEN   3392
#define XCD_BAR_WORDS 3456
#define XB_SPIN_CAP (1u << 18)
__device__ __forceinline__ unsigned xb_ld(unsigned* p)              { return __hip_atomic_load(p, __ATOMIC_RELAXED, __HIP_MEMORY_SCOPE_AGENT); }
__device__ __forceinline__ unsigned xb_add(unsigned* p, unsigned v) { return __hip_atomic_fetch_add(p, v, __ATOMIC_RELAXED, __HIP_MEMORY_SCOPE_AGENT); }
__device__ __forceinline__ unsigned xb_xcc_id() { return (unsigned)__builtin_amdgcn_s_getreg((3 << 11) | 20) & 0xFu; }
#define XB_SPIN(cond, bar) do { unsigned _sp = 0; while (cond) { __builtin_amdgcn_s_sleep(1); \
    if ((++_sp & 255u) == 0u) { if (xb_ld(&(bar)[XB_TMO])) break; if (_sp > XB_SPIN_CAP) { atomicAdd(&(bar)[XB_TMO], 1u); break; } } } } while (0)
struct XcdBarrier { unsigned* bar; unsigned x; volatile LAS unsigned* st; };
__device__ __forceinline__ XcdBarrier xcd_barrier_post(unsigned* bar, volatile LAS unsigned* st) {
    XcdBarrier b; b.bar = bar; b.x = xb_xcc_id(); b.st = st;
    if (threadIdx.x == 0) (void)xb_add(&bar[XB_XCNT(b.x)], 1u);
    return b;
}
__device__ __forceinline__ void xcd_barrier_complete(unsigned* bar, unsigned x, unsigned& nloc, unsigned& nx) {
    const unsigned G = gridDim.x * gridDim.y * gridDim.z;
    unsigned sum, cnt, mine, sp = 0u;
    for (;;) {
        sum = 0u; cnt = 0u; mine = 0u;
#pragma unroll
        for (unsigned j = 0; j < 16; ++j) { const unsigned c = xb_ld(&bar[XB_XCNT(j)]); sum += c; cnt += (c > 0u) ? 1u : 0u; mine = (j == x) ? c : mine; }
        if (sum == G) break;
        __builtin_amdgcn_s_sleep(1);
        if ((++sp & 255u) == 0u) { if (xb_ld(&bar[XB_TMO])) break; if (sp > XB_SPIN_CAP) { atomicAdd(&bar[XB_TMO], 1u); break; } }
    }
    nloc = mine > 0u ? mine : 1u; nx = cnt > 0u ? cnt : 1u;
}
__device__ __forceinline__ void xcd_barrier(const XcdBarrier& b) {
    asm volatile("s_waitcnt vmcnt(0)" ::: "memory");
    __syncthreads();
    if (threadIdx.x == 0) {
        unsigned* bar = b.bar;
        __builtin_amdgcn_s_waitcnt(0);
        unsigned nloc = b.st[0], nx = b.st[1];
        if (nloc == 0u) { xcd_barrier_complete(bar, b.x, nloc, nx); b.st[0] = nloc; b.st[1] = nx; }
        const unsigned old = xb_add(&bar[XB_XSUB(b.x)], 1u);
        const unsigned gen = old / nloc;
        if (old + 1u == (gen + 1u) * nloc) {
            __builtin_amdgcn_fence(__ATOMIC_RELEASE, "agent");
            asm volatile("s_waitcnt vmcnt(0)" ::: "memory");
            const unsigned og = xb_add(&bar[XB_TOP], 1u);
            const unsigned tg = og / nx;
            if (og + 1u == (tg + 1u) * nx) xb_add(&bar[XB_TOPGEN], 1u);
            else XB_SPIN(xb_ld(&bar[XB_TOPGEN]) == tg, bar);
            __builtin_amdgcn_fence(__ATOMIC_ACQUIRE, "agent");
            xb_add(&bar[XB_XGEN(b.x)], 1u);
            asm volatile("s_waitcnt vmcnt(0)" ::: "memory");
        } else {
            XB_SPIN(xb_ld(&bar[XB_XGEN(b.x)]) == gen, bar);
            __builtin_amdgcn_fence(__ATOMIC_ACQUIRE, "agent");
            asm volatile("s_waitcnt vmcnt(0)" ::: "memory");
        }
    }
    __syncthreads();
}

__device__ __forceinline__ float wave_sum(float v) {
#pragma unroll
    for (int o = 1; o < 64; o <<= 1) v += __shfl_xor(v, o);
    return v;
}
constexpr int TP = 272, TILE_B = 128 * TP;
__device__ __forceinline__ void tile_load(u32x4 (&r)[4], const f16* src, unsigned stride_bytes, int tid) {
    const unsigned vo = (unsigned)(tid >> 4) * stride_bytes + (unsigned)(tid & 15) * 16u;
#pragma unroll
    for (int i = 0; i < 4; ++i) r[i] = *(const u32x4*)(((const char*)src + (size_t)i * 32u * stride_bytes) + vo);
}
template <int P = TP>
__device__ __forceinline__ void tile_store(LAS unsigned char* buf, const u32x4 (&r)[4], int tid) {
    LAS unsigned char* p = buf + (tid >> 4) * P + (tid & 15) * 16;
#pragma unroll
    for (int i = 0; i < 4; ++i) *(LAS u32x4*)(p + i * 32 * P) = r[i];
}
__device__ __forceinline__ f16x8 frag_row(const LAS unsigned char* buf, int rb, int ks, int li, int g) { return *(const LAS f16x8*)(buf + (li * TP + g * 16) + (rb * 16 * TP + ks * 64)); }
template <bool PERMK, int P = TP>
__device__ __forceinline__ f16x8 frag_tr(const LAS unsigned char* buf, int kbase, int cb, int li, int g) {
    const int q = li >> 2, p = li & 3;
    const LAS unsigned char* a0 = buf + ((PERMK ? (4 * g + q) : (8 * g + q)) * P + 8 * p) + (kbase * P + 32 * cb);
    const v4i16 lo = __builtin_amdgcn_ds_read_tr16_b64_v4i16((LAS v4i16*)a0);
    const v4i16 hi = __builtin_amdgcn_ds_read_tr16_b64_v4i16((LAS v4i16*)(a0 + (PERMK ? 16 : 4) * P));
    const f16x4 l = __builtin_bit_cast(f16x4, lo), h = __builtin_bit_cast(f16x4, hi);
    return (f16x8){l[0], l[1], l[2], l[3], h[0], h[1], h[2], h[3]};
}
#ifndef STAG_SLEEP
#define STAG_SLEEP 1
#endif
#define STAGGER(w) do { if (STAG_SLEEP > 0 && (w) >= 4) __builtin_amdgcn_s_sleep(STAG_SLEEP); } while (0)
#define LBAR() do { asm volatile("s_waitcnt lgkmcnt(0)" ::: "memory"); __builtin_amdgcn_s_barrier(); asm volatile("" ::: "memory"); } while (0)
__device__ __forceinline__ u32x4 widen2(u32x2 A, u32x2 B) {
    const auto rx = __builtin_amdgcn_permlane16_swap(A.x, B.x, false, false), ry = __builtin_amdgcn_permlane16_swap(A.y, B.y, false, false);
    return (u32x4){rx[0], ry[0], rx[1], ry[1]};
}
__device__ __forceinline__ void unwiden2(u32x4 W, u32x2& A, u32x2& B) {
    const auto rx = __builtin_amdgcn_permlane16_swap(W.x, W.z, false, false), ry = __builtin_amdgcn_permlane16_swap(W.y, W.w, false, false);
    A.x = rx[0]; B.x = rx[1]; A.y = ry[0]; B.y = ry[1];
}
#define MFMA16(a, b, c) __builtin_amdgcn_mfma_f32_16x16x32_f16((a), (b), (c), 0, 0, 0)

constexpr int CONV_TOTAL = 64512, CONV_P0_END = 8192, CONV_RS0_END = 36352;
struct ConvSrc { const float *g_mix, *g_ffn, *w_ret_in, *w_ret_out, *g_kv, *w_kv, *w_att_q, *w_att_out, *w_ffn_in, *w_ffn_out; unsigned char* ws; };
struct CvItem { const float* W; const float* gain; f16* WT; int K, N, mode, bf, k0, n0; };
__device__ __forceinline__ CvItem cv_decode(const ConvSrc& c, int item) {
    CvItem t; int r, l; t.bf = 0;
    if (item < 33280) { l = item / 16640; r = item - l * 16640;
        if (r < 6144)       { t.W = c.w_ret_in + (size_t)l * DM * NRETIN; t.K = DM; t.N = NRETIN; t.gain = c.g_mix + l * DM; t.WT = (f16*)(c.ws + WS_W_RETIN) + (size_t)l * NRETIN * DM; t.mode = 0; }
        else if (r < 8192)  { r -= 6144; t.W = c.w_ret_out + (size_t)l * 4096 * DM; t.K = 4096; t.N = DM; t.gain = nullptr; t.WT = (f16*)(c.ws + WS_W_RETOUT) + (size_t)l * DM * 4096; t.mode = 0; t.bf = 1; }
        else if (r < 13824) { r -= 8192; t.W = c.w_ffn_in + (size_t)l * DM * 2 * FF; t.K = DM; t.N = 2 * FF; t.gain = c.g_ffn + l * DM; t.WT = (f16*)(c.ws + WS_W_FFNIN) + (size_t)l * 2 * FF * DM; t.mode = 1; t.bf = 1; }
        else                { r -= 13824; t.W = c.w_ffn_out + (size_t)l * FF * DM; t.K = FF; t.N = DM; t.gain = nullptr; t.WT = (f16*)(c.ws + WS_W_FFNOUT) + (size_t)l * DM * FF; t.mode = 0; t.bf = 1; }
    } else if (item < 39424) { r = item - 33280; t.W = c.w_kv; t.K = DM; t.N = NKV; t.gain = c.g_kv; t.WT = (f16*)(c.ws + WS_W_KV); t.mode = 0; t.bf = 1;
    } else { const int i3 = item - 39424; const int j = i3 / 12544; r = i3 - j * 12544; l = 2 + j;
        if (r < 3072)      { t.W = c.w_att_q + (size_t)j * DM * NATT; t.K = DM; t.N = NATT; t.gain = c.g_mix + l * DM; t.WT = (f16*)(c.ws + WS_W_Q) + (size_t)j * NATT * DM; t.mode = 0; t.bf = 1; }
        else if (r < 4096) { r -= 3072; t.W = c.w_att_out + (size_t)j * DM * DM; t.K = DM; t.N = DM; t.gain = nullptr; t.WT = (f16*)(c.ws + WS_W_ATTOUT) + (size_t)j * DM * DM; t.mode = 0; t.bf = 1; }
        else if (r < 9728) { r -= 4096; t.W = c.w_ffn_in + (size_t)l * DM * 2 * FF; t.K = DM; t.N = 2 * FF; t.gain = c.g_ffn + l * DM; t.WT = (f16*)(c.ws + WS_W_FFNIN) + (size_t)l * 2 * FF * DM; t.mode = 1; t.bf = 1; }
        else               { r -= 9728; t.W = c.w_ffn_out + (size_t)l * FF * DM; t.K = FF; t.N = DM; t.gain = nullptr; t.WT = (f16*)(c.ws + WS_W_FFNOUT) + (size_t)l * DM * FF; t.mode = 0; t.bf = 1; }
    }
    const int nnb = t.N / 64, kb = r / nnb; t.k0 = kb * 64; t.n0 = (r - kb * nnb) * 64;
    return t;
}
__device__ __forceinline__ void cv_load(const CvItem& t, float (&v)[64], int lane) {
    const float* p = t.W + (size_t)t.k0 * t.N + t.n0 + lane;
#pragma unroll
    for (int kk = 0; kk < 64; ++kk) v[kk] = p[(size_t)kk * t.N];
}
__device__ __forceinline__ void cv_store(const CvItem& t, float (&v)[64], LAS unsigned* scr, int lane) {
    if (t.gain) {
#pragma unroll
        for (int kk = 0; kk < 64; ++kk) v[kk] *= t.gain[t.k0 + kk]; }
    if (t.bf) {
#pragma unroll
        for (int p = 0; p < 32; ++p) scr[lane * 33 + p] = pk2bf(v[2 * p], v[2 * p + 1]);
    } else {
#pragma unroll
        for (int p = 0; p < 32; ++p) scr[lane * 33 + p] = pk2h(v[2 * p], v[2 * p + 1]); }
    LDS_WAIT(); asm volatile("" ::: "memory");
    const int c = lane & 7;
#pragma unroll
    for (int j = 0; j < 8; ++j) { const int n = (lane >> 3) + 8 * j; const LAS unsigned* sp = scr + n * 33 + 4 * c;
        u32x4 o; o.x = sp[0]; o.y = sp[1]; o.z = sp[2]; o.w = sp[3];
        const int ns = t.n0 + n; int row = ns;
        if (t.mode == 1) { row = (ns < FF) ? (256 * (ns >> 7) + (ns & 127)) : (256 * ((ns - FF) >> 7) + 128 + ((ns - FF) & 127)); }
        *(u32x4*)(t.WT + (size_t)row * t.K + t.k0 + 8 * c) = o; }
    LDS_WAIT(); asm volatile("" ::: "memory");
}
__device__ __forceinline__ void conv_all(const ConvSrc c, int lo, int hi, int gw, int NGW, LAS unsigned* scr, int lane) {
    int it = lo + gw;
    if (it >= hi) return;
    float va[64], vb[64];
    CvItem ca = cv_decode(c, it), cb = ca;
    cv_load(ca, va, lane);
    for (;;) {
        const bool hb = (it + NGW) < hi;
        if (hb) { cb = cv_decode(c, it + NGW); cv_load(cb, vb, lane); }
        cv_store(ca, va, scr, lane);
        if (!hb) break;
        it += NGW;
        const bool ha = (it + NGW) < hi;
        if (ha) { ca = cv_decode(c, it + NGW); cv_load(ca, va, lane); }
        cv_store(cb, vb, scr, lane);
        if (!ha) break;
        it += NGW;
    }
}
__device__ __forceinline__ void sincos_d(double a, double& s, double& c) {
    const double k = __builtin_rint(a * 0.63661977236758134308);
    double r = __builtin_fma(-k, 1.57079632679489655800e+00, a); r = __builtin_fma(-k, 6.12323399573676603587e-17, r);
    const double r2 = r * r;
    double ps = -1.0 / 121645100408832000.0;
    ps = ps * r2 + 1.0 / 355687428096000.0;  ps = ps * r2 - 1.0 / 1307674368000.0; ps = ps * r2 + 1.0 / 6227020800.0; ps = ps * r2 - 1.0 / 39916800.0;
    ps = ps * r2 + 1.0 / 362880.0; ps = ps * r2 - 1.0 / 5040.0; ps = ps * r2 + 1.0 / 120.0; ps = ps * r2 - 1.0 / 6.0; ps = ps * r2 + 1.0;
    const double sn = ps * r;
    double pc = 1.0 / 6402373705728000.0;
    pc = pc * r2 - 1.0 / 20922789888000.0; pc = pc * r2 + 1.0 / 87178291200.0; pc = pc * r2 - 1.0 / 479001600.0; pc = pc * r2 + 1.0 / 3628800.0;
    pc = pc * r2 - 1.0 / 40320.0; pc = pc * r2 + 1.0 / 720.0; pc = pc * r2 - 1.0 / 24.0; pc = pc * r2 + 0.5; const double cs = 1.0 - pc * r2;
    const int q = ((int)k) & 3;
    s = (q == 0) ? sn : (q == 1) ? cs : (q == 2) ? -sn : -cs;
    c = (q == 0) ? cs : (q == 1) ? -sn : (q == 2) ? -cs : sn;
}

template <int NET>
__device__ __forceinline__ void ret_state_phase(LAS unsigned char* lds, const f16* __restrict__ Z, f16* __restrict__ ST, int unit0, int ustride) {
    constexpr int NS = 32 / NET, VP = 32 * NET + 32, NVR = NET / 2, KP = 288, KTB = 128 * KP;
    const int tid = opaque_tid();
    const int lane = tid & 63, w = __builtin_amdgcn_readfirstlane(tid >> 6), li = lane & 15, g = lane >> 4, q = li >> 2, p = li & 3;
    LAS unsigned char* kimg = lds; LAS unsigned char* vimg = lds + 2 * KTB;
    for (int u = unit0; u < BATCH * RH * NS; u += ustride) {
        const int b = u / (RH * NS), h = (u / NS) % RH, es = u % NS;
        const float l2g = log2f(1.0f - exp2f(-5.0f - (float)h)), cdec = exp2f(128.0f * l2g);
        const f16* zb = Z + (size_t)b * SEQ * NRETIN;
        const f16* ksrc = zb + 2048 + h * 256; const f16* vsrc = zb + 4096 + h * 512 + es * (16 * NET);
        f16* stb = ST + (size_t)((b * RH + h) * NCH) * (RDV * RDK) + (size_t)(es * 16 * NET) * RDK;
        const float vscale = exp2f((float)(127 - (tid >> 2)) * l2g);
        const unsigned vo = (unsigned)((tid >> 2) * NRETIN + (tid & 3) * 8 * NVR) * 2u;
        f32x4 R[2][NET];
#pragma unroll
        for (int a = 0; a < 2; ++a)
#pragma unroll
            for (int c2 = 0; c2 < NET; ++c2) R[a][c2] = (f32x4){0.f, 0.f, 0.f, 0.f};
        u32x4 kr[2][2][4], vr[2][NVR];
#define RS_LOAD(set, c) do { const f16* kc = ksrc + (size_t)(c) * RC * NRETIN; tile_load(kr[set][0], kc, NRETIN * 2, tid); tile_load(kr[set][1], kc + 128, NRETIN * 2, tid); \
            _Pragma("unroll") for (int i = 0; i < NVR; ++i) vr[set][i] = *(const u32x4*)((const char*)(vsrc + (size_t)(c) * RC * NRETIN) + vo + 16u * i); } while (0)
#define RS_STEP(set, c) do { \
            LBAR(); \
            tile_store<KP>(kimg, kr[set][0], tid); tile_store<KP>(kimg + KTB, kr[set][1], tid); \
            _Pragma("unroll") for (int i = 0; i < NVR; ++i) { const f16x8 vv = __builtin_bit_cast(f16x8, vr[set][i]); f16x8 o; \
              _Pragma("unroll") for (int j = 0; j < 8; ++j) o[j] = (f16)((float)vv[j] * vscale); \
              *(LAS f16x8*)(vimg + (tid >> 2) * VP + (tid & 3) * 16 * NVR + 16 * i) = o; } \
            LBAR(); STAGGER(w); \
            RS_LOAD(set, ((c) + 2 < NCH) ? (c) + 2 : NCH - 1);        \
            { f16* sp = stb + (size_t)(c) * (RDV * RDK);                  \
                _Pragma("unroll") for (int et = 0; et < NET; ++et) { u32x2 o0, o1; o0.x = pk2h(R[0][et][0], R[0][et][1]); o0.y = pk2h(R[0][et][2], R[0][et][3]); o1.x = pk2h(R[1][et][0], R[1][et][1]); o1.y = pk2h(R[1][et][2], R[1][et][3]); \
                    *(u32x4*)(sp + (size_t)(16 * et + li) * RDK + 32 * w + 16 * (g & 1) + 8 * (g >> 1)) = widen2(o0, o1); } } \
            _Pragma("unroll") for (int dt = 0; dt < 2; ++dt) _Pragma("unroll") for (int et = 0; et < NET; ++et) R[dt][et] = R[dt][et] * cdec; \
            const LAS unsigned char* kt = kimg + (w >> 2) * KTB; \
            _Pragma("unroll") for (int ks = 0; ks < 4; ++ks) { \
                f16x8 bf[NET]; \
                _Pragma("unroll") for (int et = 0; et < NET; ++et) { \
                    const LAS unsigned char* a0 = vimg + (32 * ks + 4 * g + q) * VP + 32 * et + 8 * p; \
                    const v4i16 lo = __builtin_amdgcn_ds_read_tr16_b64_v4i16((LAS v4i16*)a0), hi = __builtin_amdgcn_ds_read_tr16_b64_v4i16((LAS v4i16*)(a0 + 16 * VP)); \
                    const f16x4 l = __builtin_bit_cast(f16x4, lo), hh = __builtin_bit_cast(f16x4, hi); \
                    bf[et] = (f16x8){l[0], l[1], l[2], l[3], hh[0], hh[1], hh[2], hh[3]}; } \
                _Pragma("unroll") for (int dt = 0; dt < 2; ++dt) { const f16x8 af = frag_tr<true, KP>(kt, 32 * ks, 2 * (w & 3) + dt, li, g); \
                    _Pragma("unroll") for (int et = 0; et < NET; ++et) R[dt][et] = MFMA16(af, bf[et], R[dt][et]); } } \
        } while (0)
        RS_LOAD(0, 0); RS_LOAD(1, 1);
        RS_STEP(0, 0); RS_STEP(1, 1);
        for (int c = 2; c < NCH; c += 2) { RS_STEP(0, c); RS_STEP(1, c + 1); }
#undef RS_LOAD
#undef RS_STEP
        LBAR();
    }
}

struct RoUnit { const f16* zc; const f16* stc; const f16* ksrc; const f16* vsrc; int h; bool hasr; size_t tok0; };
__device__ __forceinline__ RoUnit ro_decode(int u, const f16* Z, const f16* ST) {
    RoUnit r; const int b = u >> 9, h = (u >> 6) & 7, c = u & 63;
    r.h = h; r.hasr = c > 0; r.tok0 = (size_t)b * SEQ + (size_t)c * RC; r.zc = Z + r.tok0 * NRETIN;
    r.stc = ST + (size_t)((b * RH + h) * NCH + c) * (RDV * RDK); r.ksrc = r.zc + 2048 + h * 256; r.vsrc = r.zc + 4096 + h * 512;
    return r;
}
__device__ __forceinline__ void ret_out_phase(LAS unsigned char* lds, const f16* __restrict__ Z, const f16* __restrict__ ST, f16* __restrict__ Y, int G, int bid) {
    constexpr int NU = BATCH * RH * NCH;
    if (bid >= NU) return;
    RoUnit cur = ro_decode(bid, Z, ST);
    f16x8 Qf[8];
    u32x4 pre[2][4];
    int tid = opaque_tid(), lane = tid & 63, li = lane & 15, g = lane >> 4;
    const int w = __builtin_amdgcn_readfirstlane(tid >> 6);
    unsigned qo = (unsigned)((16 * w + li) * NRETIN + 8 * g) * 2u;
#define RO_LOADQ(un) do { const char* qb_ = (const char*)((un).zc + (un).h * 256); _Pragma("unroll") for (int ks = 0; ks < 8; ++ks) Qf[ks] = *(const f16x8*)(qb_ + (qo + 64u * ks)); } while (0)
#define RO_LDK(set, un, kd)      tile_load(pre[set], (un).ksrc + (kd) * 128, NRETIN * 2, tid)
#define RO_LDR(set, un, eb, kd)  tile_load(pre[set], (un).stc + (size_t)((eb) * 128) * RDK + (kd) * 128, RDK * 2, tid)
#define RO_LDV(set, un, eb)      tile_load(pre[set], (un).vsrc + (eb) * 128, NRETIN * 2, tid)
    RO_LOADQ(cur); RO_LDK(0, cur, 0); RO_LDK(1, cur, 1);
    for (int u = bid; u < NU; u += G) {
        const bool has_next = (u + G) < NU;
        const RoUnit nxt = ro_decode(has_next ? u + G : u, Z, ST);
        const bool hasr = cur.hasr;
        tid = opaque_tid(); lane = tid & 63; li = lane & 15; g = lane >> 4;
        qo = (unsigned)((16 * w + li) * NRETIN + 8 * g) * 2u;
        LAS unsigned char* parkL = lds + 2 * TILE_B + w * 8192 + lane * 8;
        const float l2g = log2f(1.0f - exp2f(-5.0f - (float)cur.h));
        f16x8 Sf[4];
        {
            f32x4 St[8];
#pragma unroll
            for (int jt = 0; jt < 8; ++jt) St[jt] = (f32x4){0.f, 0.f, 0.f, 0.f};
#pragma unroll
            for (int kd = 0; kd < 2; ++kd) {
                LAS unsigned char* buf = lds + kd * TILE_B;
                tile_store(buf, pre[kd], tid); LBAR(); STAGGER(w);
                if (hasr) RO_LDR(kd, cur, kd, 0); else RO_LDV(kd, cur, kd);
#pragma unroll
                for (int jt = 0; jt < 8; ++jt) if (jt <= w)
#pragma unroll
                    for (int ks = 0; ks < 4; ++ks) { St[jt] = MFMA16(frag_row(buf, jt, ks, li, g), Qf[4 * kd + ks], St[jt]); if (ks == 3) __builtin_amdgcn_sched_barrier(0); }
            }
            const int tq = opaque_tid(), i = 16 * w + (tq & 15), gq = (tq >> 4) & 3;
#pragma unroll
            for (int jt = 0; jt < 8; ++jt)
#pragma unroll
                for (int r = 0; r < 4; ++r) { const int j = 16 * jt + 4 * gq + r; St[jt][r] = (i >= j) ? St[jt][r] * __builtin_amdgcn_exp2f((float)(i - j) * l2g) : 0.f; }
#pragma unroll
            for (int s = 0; s < 4; ++s) Sf[s] = (f16x8){(f16)St[2 * s][0], (f16)St[2 * s][1], (f16)St[2 * s][2], (f16)St[2 * s][3], (f16)St[2 * s + 1][0], (f16)St[2 * s + 1][1], (f16)St[2 * s + 1][2], (f16)St[2 * s + 1][3]};
        }
        const float qd = __builtin_amdgcn_exp2f((float)(16 * w + li + 1) * l2g);
        float sq = 0.f;
        f32x4 acc[16];
#pragma unroll
        for (int hf = 0; hf < 2; ++hf) {
#pragma unroll
            for (int a = 0; a < 16; ++a) acc[a] = (f32x4){0.f, 0.f, 0.f, 0.f};
            if (hasr) {
#pragma unroll
                for (int rr = 0; rr < 4; ++rr) {
                    LAS unsigned char* buf = lds + (rr & 1) * TILE_B;
                    tile_store(buf, pre[rr & 1], tid); LBAR(); STAGGER(w);
                    if (rr < 2) RO_LDR(rr & 1, cur, 2 * hf + (rr & 1), 1); else RO_LDV(rr & 1, cur, 2 * hf + (rr & 1));
                    const int ebl = rr & 1, kd = rr >> 1;
#pragma unroll
                    for (int et = 0; et < 8; ++et)
#pragma unroll
                        for (int ks = 0; ks < 4; ++ks) { acc[8 * ebl + et] = MFMA16(frag_row(buf, et, ks, li, g), Qf[4 * kd + ks], acc[8 * ebl + et]); if (ks == 3) __builtin_amdgcn_sched_barrier(0); }
                }
#pragma unroll
                for (int a = 0; a < 16; ++a) acc[a] = acc[a] * qd;
            }
#pragma unroll
            for (int ebl = 0; ebl < 2; ++ebl) {
                LAS unsigned char* buf = lds + ebl * TILE_B;
                tile_store(buf, pre[ebl], tid); LBAR(); STAGGER(w);
                if (hf == 0) { if (hasr) RO_LDR(ebl, cur, 2 + ebl, 0); else RO_LDV(ebl, cur, 2 + ebl); }
                else if (has_next) RO_LDK(ebl, nxt, ebl);
#pragma unroll
                for (int et = 0; et < 8; ++et)
#pragma unroll
                    for (int s = 0; s < 4; ++s) { if (2 * s <= w) acc[8 * ebl + et] = MFMA16(frag_tr<true>(buf, 32 * s, et, li, g), Sf[s], acc[8 * ebl + et]); if (s == 3) __builtin_amdgcn_sched_barrier(0); }
            }
#pragma unroll
            for (int a = 0; a < 16; ++a) sq += (acc[a][0] * acc[a][0] + acc[a][1] * acc[a][1]) + (acc[a][2] * acc[a][2] + acc[a][3] * acc[a][3]);
            if (hf == 0) {
#pragma unroll
                for (int a = 0; a < 16; ++a) { u32x2 o; o.x = pk2h(acc[a][0], acc[a][1]); o.y = pk2h(acc[a][2], acc[a][3]); *(LAS u32x2*)(parkL + 512 * a) = o; }
            }
        }
        sq += __shfl_xor(sq, 16); sq += __shfl_xor(sq, 32);
        const float rs = __builtin_amdgcn_rsqf(sq * (1.0f / RDV) + NORM_EPS);
        const int t2 = opaque_tid(), li2 = t2 & 15, g2 = (t2 >> 4) & 3;
        const unsigned cw = 16 * (g2 & 1) + 8 * (g2 >> 1);
        const unsigned go = (unsigned)((16 * w + li2) * NRETIN) + cw, yo = (unsigned)((16 * w + li2) * 4096) + cw;
        const f16* gp = (cur.zc + 8192 + cur.h * 512) + go; f16* yp = (Y + cur.tok0 * 4096 + cur.h * 512) + yo;
        u32x4 gw[8];
#pragma unroll
        for (int a = 0; a < 8; ++a) gw[a] = *(const u32x4*)(gp + 32 * a);
#pragma unroll
        for (int a = 0; a < 8; ++a) { u32x2 g0, g1; unwiden2(gw[a], g0, g1); const f16x4 ga = __builtin_bit_cast(f16x4, g0), gb = __builtin_bit_cast(f16x4, g1);
            const f16x4 pa = __builtin_bit_cast(f16x4, *(const LAS u32x2*)(parkL + 512 * (2 * a))), pb = __builtin_bit_cast(f16x4, *(const LAS u32x2*)(parkL + 512 * (2 * a + 1)));
            u32x2 o0, o1; o0.x = pk2bf((float)pa[0] * rs * (float)ga[0], (float)pa[1] * rs * (float)ga[1]); o0.y = pk2bf((float)pa[2] * rs * (float)ga[2], (float)pa[3] * rs * (float)ga[3]);
            o1.x = pk2bf((float)pb[0] * rs * (float)gb[0], (float)pb[1] * rs * (float)gb[1]); o1.y = pk2bf((float)pb[2] * rs * (float)gb[2], (float)pb[3] * rs * (float)gb[3]);
            *(u32x4*)(yp + 32 * a) = widen2(o0, o1); }
#pragma unroll
        for (int a = 0; a < 8; ++a) gw[a] = *(const u32x4*)(gp + 256 + 32 * a);
#pragma unroll
        for (int a = 0; a < 8; ++a) { u32x2 g0, g1; unwiden2(gw[a], g0, g1); const f16x4 ga = __builtin_bit_cast(f16x4, g0), gb = __builtin_bit_cast(f16x4, g1);
            const f32x4 av = acc[2 * a], bv = acc[2 * a + 1];
            u32x2 o0, o1; o0.x = pk2bf(av[0] * rs * (float)ga[0], av[1] * rs * (float)ga[1]); o0.y = pk2bf(av[2] * rs * (float)ga[2], av[3] * rs * (float)ga[3]);
            o1.x = pk2bf(bv[0] * rs * (float)gb[0], bv[1] * rs * (float)gb[1]); o1.y = pk2bf(bv[2] * rs * (float)gb[2], bv[3] * rs * (float)gb[3]);
            *(u32x4*)(yp + 256 + 32 * a) = widen2(o0, o1); }
        __builtin_amdgcn_sched_barrier(0);
        if (has_next) RO_LOADQ(nxt);
        cur = nxt;
    }
#undef RO_LOADQ
#undef RO_LDK
#undef RO_LDR
#undef RO_LDV
    LBAR();
}

constexpr int BIAS_ROW = 160, BIAS_PAD = 16;
struct AttUnit { const f16* k0; const f16* k1; const f16* q; unsigned kstride; int gi, hs, d, lse0; bool hasp, cont; size_t tok0; };
__device__ __forceinline__ AttUnit att_decode(int k, int bid, int G, const f16* KV, const f16* QA) {
    AttUnit a; const int u = (bid + (k >> 2) * G) * 4 + (k & 3);
    const int gi = u >> 11, rem = u & 2047, b = rem >> 10, hs = (rem >> 6) & 15, rb = rem & 63, dsh = 2 * gi, d = 1 << dsh, nb = rb & ((64 >> dsh) - 1), r = rb >> (6 - dsh);
    a.gi = gi; a.hs = hs; a.d = d; a.hasp = nb > 0; a.cont = (k & 3) != 0; a.tok0 = (size_t)b * SEQ + r + (size_t)(nb * 128) * d;
    a.lse0 = ((gi * 16 + hs) * BATCH + b) * SEQ + r * (SEQ >> dsh) + nb * 128;
    a.k1 = KV + a.tok0 * NKV + gi * 2048 + hs * 128; a.k0 = a.k1 - (size_t)128 * d * NKV; a.kstride = (unsigned)d * NKV * 2u;
    a.q = QA + a.tok0 * NATT + gi * 2048 + hs * 128;
    return a;
}
__device__ __forceinline__ void att_phase(const bool MERGE, LAS unsigned char* lds, const f16* __restrict__ KV, const f16* __restrict__ QA, f16* OG, float* LSE,
                                          const float* __restrict__ biasT, int G, int bid0, int run0, int nrun, f16* __restrict__ O16) {
    const int bid = run0 + bid0;
    const int tid = opaque_tid();
    const int lane = tid & 63, w = __builtin_amdgcn_readfirstlane(tid >> 6), li = lane & 15, g = lane >> 4;
    LAS float* biasL = (LAS float*)(lds + 4 * TILE_B);
    const int nk = (bid0 < nrun) ? 4 * ((nrun - 1 - bid0) / G + 1) : 0;
    if (nk == 0) return;
    AttUnit cur = att_decode(0, bid, G, KV, QA);
    u32x4 A[4], B[4]; f16x8 Qn[4]; float bn = 0.f;
    const int bc = tid - BIAS_PAD;
    { const char* qb = (const char*)cur.q; const unsigned qo = (unsigned)((16 * w + li) * cur.d) * (unsigned)(NATT * 2) + 16u * g;
#pragma unroll
      for (int ks = 0; ks < 4; ++ks) Qn[ks] = *(const f16x8*)(qb + (qo + 64u * ks)); }
    if (bc >= 0 && bc <= 128) bn = biasT[(cur.gi * 16 + cur.hs) * BIAS_PITCH + bc];
    __builtin_amdgcn_sched_barrier(0);
    if (cur.hasp) tile_load(A, cur.k0, cur.kstride, tid);
    tile_load(B, cur.k1, cur.kstride, tid);
    int sel = 0;
    for (int k = 0; k < nk; ++k) {
        const bool has_next = (k + 1) < nk;
        const AttUnit nxt = att_decode(has_next ? k + 1 : k, bid, G, KV, QA);
        f16x8 Qf[4];
#pragma unroll
        for (int ks = 0; ks < 4; ++ks) Qf[ks] = Qn[ks];
        const bool hasp = cur.hasp, fresh = !cur.cont;
        if (cur.cont) sel ^= 1;
        LAS unsigned char* bKc = lds + sel * TILE_B; LAS unsigned char* bKp = lds + (sel ^ 1) * TILE_B;
        LAS unsigned char* bVc = lds + (2 + sel) * TILE_B; LAS unsigned char* bVp = lds + (2 + (sel ^ 1)) * TILE_B;
        if (fresh && hasp) tile_store(bKp, A, tid);
        tile_store(bKc, B, tid);
        if (tid < BIAS_ROW) biasL[tid] = bn;
        LBAR(); STAGGER(w);
        if (fresh && hasp) tile_load(A, cur.k0 + NATT, cur.kstride, tid);
        tile_load(B, cur.k1 + NATT, cur.kstride, tid);
        f32x4 St[16];
#pragma unroll
        for (int t = 0; t < 16; ++t) St[t] = (f32x4){0.f, 0.f, 0.f, 0.f};
        if (hasp) {
#pragma unroll
            for (int T = 0; T < 8; ++T) if (T >= w) {
#pragma unroll
                for (int ks = 0; ks < 4; ++ks) St[T] = MFMA16(frag_row(bKp, T, ks, li, g), Qf[ks], St[T]);
                __builtin_amdgcn_sched_barrier(0); }
        }
#pragma unroll
        for (int T = 0; T < 8; ++T) if (T <= w) {
#pragma unroll
            for (int ks = 0; ks < 4; ++ks) St[8 + T] = MFMA16(frag_row(bKc, T, ks, li, g), Qf[ks], St[8 + T]);
            __builtin_amdgcn_sched_barrier(0); }
        const int tq = opaque_tid(), liq = tq & 15, gq = (tq >> 4) & 3;
        const LAS float* bl = biasL + BIAS_PAD + (liq - 4 * gq);
        float mx = -INFINITY;
        if (hasp) {
#pragma unroll
            for (int T = 0; T < 8; ++T) if (T >= w) { const bool diag = (T == w);
#pragma unroll
                for (int rg = 0; rg < 4; ++rg) { float sv = St[T][rg] + bl[128 + 16 * (w - T) - rg]; if (diag && (4 * gq + rg < liq)) sv = -INFINITY; St[T][rg] = sv; mx = fmaxf(mx, sv); } }
        }
#pragma unroll
        for (int T = 0; T < 8; ++T) if (T <= w) { const bool diag = (T == w);
#pragma unroll
            for (int rg = 0; rg < 4; ++rg) { float sv = St[8 + T][rg] + bl[16 * (w - T) - rg]; if (diag && (4 * gq + rg > liq)) sv = -INFINITY; St[8 + T][rg] = sv; mx = fmaxf(mx, sv); } }
        mx = fmaxf(mx, __shfl_xor(mx, 16)); mx = fmaxf(mx, __shfl_xor(mx, 32));
        float den = 0.f;
        if (hasp) {
#pragma unroll
            for (int T = 0; T < 8; ++T) if (T >= w) {
#pragma unroll
                for (int rg = 0; rg < 4; ++rg) { const float pv = __builtin_amdgcn_exp2f(St[T][rg] - mx); St[T][rg] = pv; den += pv; } }
        }
#pragma unroll
        for (int T = 0; T < 8; ++T) if (T <= w) {
#pragma unroll
            for (int rg = 0; rg < 4; ++rg) { const float pv = __builtin_amdgcn_exp2f(St[8 + T][rg] - mx); St[8 + T][rg] = pv; den += pv; } }
        den += __shfl_xor(den, 16); den += __shfl_xor(den, 32);
        f16x8 Pf[8];
#pragma unroll
        for (int s = 0; s < 8; ++s) Pf[s] = (f16x8){(f16)St[2 * s][0], (f16)St[2 * s][1], (f16)St[2 * s][2], (f16)St[2 * s][3], (f16)St[2 * s + 1][0], (f16)St[2 * s + 1][1], (f16)St[2 * s + 1][2], (f16)St[2 * s + 1][3]};
        if (fresh && hasp) tile_store(bVp, A, tid);
        tile_store(bVc, B, tid);
        LBAR(); STAGGER(w);
        if (has_next) {
            const char* qb = (const char*)nxt.q; const unsigned qo = (unsigned)((16 * w + li) * nxt.d) * (unsigned)(NATT * 2) + 16u * g;
#pragma unroll
            for (int ks = 0; ks < 4; ++ks) Qn[ks] = *(const f16x8*)(qb + (qo + 64u * ks));
            if (bc >= 0 && bc <= 128) bn = biasT[(nxt.gi * 16 + nxt.hs) * BIAS_PITCH + bc];
            __builtin_amdgcn_sched_barrier(0);
            if (!nxt.cont && nxt.hasp) tile_load(A, nxt.k0, nxt.kstride, tid);
            tile_load(B, nxt.k1, nxt.kstride, tid);
        }
        u32x4 mo1[4], mo2[4]; float ml1 = 0.f, ml2 = 0.f;
        if (MERGE) {
            const int t = (cur.lse0 & (SEQ - 1)) + 16 * w + liq, hb = cur.lse0 - (cur.lse0 & (SEQ - 1));
            const int r1 = hb + 16 * BATCH * SEQ + (t & 3) * (SEQ >> 2) + (t >> 2), r2 = hb + 32 * BATCH * SEQ + (t & 15) * (SEQ >> 4) + (t >> 4);
            const unsigned cw = 16 * (gq & 1) + 8 * (gq >> 1);
            const f16* p1 = OG + (size_t)r1 * 128 + cw; const f16* p2 = OG + (size_t)r2 * 128 + cw;
#pragma unroll
            for (int j = 0; j < 4; ++j) { mo1[j] = *(const u32x4*)(p1 + 32 * j); mo2[j] = *(const u32x4*)(p2 + 32 * j); }
            ml1 = LSE[r1]; ml2 = LSE[r2];
        }
        f32x4 O[8];
#pragma unroll
        for (int et = 0; et < 8; ++et) O[et] = (f32x4){0.f, 0.f, 0.f, 0.f};
        if (hasp) {
#pragma unroll
            for (int s = 0; s < 4; ++s) if (2 * s + 1 >= w) {
#pragma unroll
                for (int et = 0; et < 8; ++et) O[et] = MFMA16(frag_tr<true>(bVp, 32 * s, et, li, g), Pf[s], O[et]);
                __builtin_amdgcn_sched_barrier(0); }
        }
#pragma unroll
        for (int s = 0; s < 4; ++s) if (2 * s <= w) {
#pragma unroll
            for (int et = 0; et < 8; ++et) O[et] = MFMA16(frag_tr<true>(bVc, 32 * s, et, li, g), Pf[4 + s], O[et]);
            __builtin_amdgcn_sched_barrier(0); }
        const float inv = 1.0f / den;
        if (!MERGE) {
            f16* op = OG + (size_t)(cur.lse0 + 16 * w + liq) * 128 + 16 * (gq & 1) + 8 * (gq >> 1);
#pragma unroll
            for (int et = 0; et < 8; et += 2) { u32x2 o0, o1; o0.x = pk2h(O[et][0] * inv, O[et][1] * inv); o0.y = pk2h(O[et][2] * inv, O[et][3] * inv); o1.x = pk2h(O[et + 1][0] * inv, O[et + 1][1] * inv); o1.y = pk2h(O[et + 1][2] * inv, O[et + 1][3] * inv);
                *(u32x4*)(op + 16 * et) = widen2(o0, o1); }
            if (gq == 0) LSE[cur.lse0 + 16 * w + liq] = (mx + __log2f(den)) * 0.6931471805599453f;
        } else {
            const float l0 = (mx + __log2f(den)) * 0.6931471805599453f, mm = fmaxf(l0, fmaxf(ml1, ml2));
            float w0 = __expf(l0 - mm), w1 = __expf(ml1 - mm), w2 = __expf(ml2 - mm); const float iw = 1.0f / (w0 + w1 + w2); w0 *= iw * inv; w1 *= iw; w2 *= iw;
            f16* op = O16 + (cur.tok0 + (size_t)(16 * w + liq)) * DM + cur.hs * 128 + 16 * (gq & 1) + 8 * (gq >> 1);
#pragma unroll
            for (int et = 0; et < 8; et += 2) { float c[8];
#pragma unroll
                for (int i = 0; i < 4; ++i) { const float fa = O[et][i], fb = O[et + 1][i]; const auto rr = __builtin_amdgcn_permlane16_swap(__builtin_bit_cast(unsigned, fa), __builtin_bit_cast(unsigned, fb), false, false);
                    c[i] = __builtin_bit_cast(float, (unsigned)rr[0]); c[4 + i] = __builtin_bit_cast(float, (unsigned)rr[1]); }
                const f16x8 a1 = __builtin_bit_cast(f16x8, mo1[et >> 1]), a2 = __builtin_bit_cast(f16x8, mo2[et >> 1]);
#pragma unroll
                for (int e = 0; e < 8; ++e) c[e] = w0 * c[e] + w1 * (float)a1[e] + w2 * (float)a2[e];
                u32x4 o; o.x = pk2bf(c[0], c[1]); o.y = pk2bf(c[2], c[3]); o.z = pk2bf(c[4], c[5]); o.w = pk2bf(c[6], c[7]);
                *(u32x4*)(op + 16 * et) = o; }
        }
        cur = nxt;
    }
    LBAR();
}
struct Args { const float* in[13]; float* out; unsigned char* ws; int ph_lo, ph_hi; };
constexpr int N_PHASES = 26;

__global__ void __launch_bounds__(NWAVES * 64, 2) yoco_fwd(Args args) {
    extern __shared__ __attribute__((aligned(16))) unsigned char lds_raw[];
    LAS unsigned char* lds = (LAS unsigned char*)lds_raw;
    volatile LAS unsigned* MISC = (volatile LAS unsigned*)(lds + MISC_OFF);
    const int G = gridDim.x, bid = blockIdx.x;
    const int vcu = (G % 8 == 0) ? (bid % 8) * (G / 8) + bid / 8 : bid;
    unsigned char* ws = args.ws;
    unsigned* ctl = (unsigned*)(ws + WS_CTL);
    const float* x_in = args.in[0]; const float* g_mix = args.in[1]; const float* g_ffn = args.in[2]; const float* w_ret_in = args.in[3]; const float* w_ret_out = args.in[4];
    const float* g_kv = args.in[5]; const float* w_kv = args.in[6]; const float* w_att_q = args.in[7]; const float* w_att_out = args.in[8]; const float* rel_bias = args.in[9];
    const float* w_ffn_in = args.in[10]; const float* w_ffn_out = args.in[11]; const float* g_final = args.in[12];
    const ConvSrc cs{g_mix, g_ffn, w_ret_in, w_ret_out, g_kv, w_kv, w_att_q, w_att_out, w_ffn_in, w_ffn_out, ws};
    float* xres = args.out;
    float* ss = (float*)(ws + WS_CTL + CTL_SS);
    float* cosT = (float*)(ws + WS_COS); float* sinT = (float*)(ws + WS_SIN); float* biasT = (float*)(ws + WS_BIAS); float* LSE = (float*)(ws + WS_LSE);
    f16* X16 = (f16*)(ws + WS_X16); f16* XB16 = (f16*)(ws + WS_XB16);
    for (int u = opaque_tid(); u < (LDS_BYTES - LDSCTL_OFF) / 4; u += NWAVES * 64) ((LAS unsigned*)(lds + LDSCTL_OFF))[u] = 0u;
    __syncthreads();
    XcdBarrier bar; bar.bar = ctl + CW_BAR; bar.x = 0; bar.st = nullptr;
    if (MK_N_LAUNCHES == 1) bar = xcd_barrier_post(ctl + CW_BAR, MISC + 8);
    const int lo = args.ph_lo, hi = args.ph_hi;
    int ph = 0;
#define RUN(k) (lo <= (k) && (k) < hi)
#define SEAM(k) do { if ((k) + 1 < hi) xcd_barrier(bar); } while (0)

    if (RUN(ph)) {
#if EN_P0
        for (int rep = 0; rep < REP_P0; ++rep) {
        const int tid = opaque_tid(), lane = tid & 63, wave = __builtin_amdgcn_readfirstlane(tid >> 6);
        const int gw = vcu * NWAVES + wave, NGW = G * NWAVES;
        LAS unsigned* scr = (LAS unsigned*)(lds + wave * 8448);
        conv_all(cs, 0, CONV_P0_END, gw, NGW, scr, lane);
        for (int m = gw; m < M; m += NGW) {
            const f32x4* xr = (const f32x4*)(x_in + (size_t)m * DM) + lane; f32x4 v[8]; float s = 0.f;
#pragma unroll
            for (int j = 0; j < 8; ++j) { v[j] = xr[64 * j]; s += (v[j][0] * v[j][0] + v[j][1] * v[j][1]) + (v[j][2] * v[j][2] + v[j][3] * v[j][3]); }
            s = wave_sum(s); if (lane == 0) ss[m] = s;
            u32x2* o8 = (u32x2*)(X16 + (size_t)m * DM) + lane;
#pragma unroll
            for (int j = 0; j < 8; ++j) { u32x2 o; o.x = pk2h(v[j][0], v[j][1]); o.y = pk2h(v[j][2], v[j][3]); o8[64 * j] = o; }
        }
        const int gt = vcu * 512 + tid, NGT = G * 512;
        for (int idx = gt; idx < SEQ * 128; idx += NGT) {
            const int pos = idx >> 7, i = idx & 127;
            const float inv = (float)(1.0 / exp2((double)i * (1.0 / 127.0) * 13.287712379549449));
            const float ang = __fmul_rn((float)pos, inv);
            double s, c; sincos_d((double)ang, s, c); cosT[idx] = (float)c; sinT[idx] = (float)s;
        }
        for (int idx = gt; idx < 48 * 129; idx += NGT) {
            const int gh = idx / 129, delta = idx - gh * 129, gi = gh >> 4, n = delta << (2 * gi);
            int bk = n;
            if (n >= 16) { bk = 16 + (int)(log((double)n / 16.0) / log(128.0) * 16.0); bk = bk > 31 ? 31 : bk; }
            biasT[gh * BIAS_PITCH + delta] = rel_bias[bk * 48 + gh] * 1.4426950408889634f;
        }
        __syncthreads();
        }
#endif
        SEAM(ph);
    }
    ++ph;

    for (int l = 0; l < 4; ++l) {
        const float* ss_mix = ss + (size_t)(2 * l) * M; float* ss_ffn = ss + (size_t)(2 * l + 1) * M; float* ss_next = ss + (size_t)(2 * l + 2) * M;
        const f16* mixA; const f16* mixB; int mixK;
        f16* HID;
        if (l < 2) {
            f16* Z16 = (f16*)(ws + WS_Z16); f16* STATE = (f16*)(ws + WS_STATE); f16* Yb = (f16*)(ws + WS_Y);
            if (RUN(ph)) {
                pg8::Gemm gm{X16, (const f16*)(ws + WS_W_RETIN) + (size_t)l * NRETIN * DM, M, NRETIN, DM}; pg8::StaticOrder S; S.init(M, NRETIN, G, bid);
                pg8::EpiRetIn E{Z16, ss_mix, cosT, sinT};

#if EN_G1
 pg8::gemm_phase<pg8::EpiRetIn, pg8::StaticOrder>(lds, gm, S, E);
#endif

                SEAM(ph);
            }
            ++ph;
            if (RUN(ph)) {
#if EN_RS
                const int half = (bid >> 3) & 1, sub = (bid >> 4) * 8 + (bid & 7), nhalf = G >> 1;
                if (half == 0) ret_state_phase<4>(lds, Z16, STATE, (G == 256) ? ((sub & 7) * 16 + (sub >> 3)) : sub, nhalf);
                else { const int t2 = opaque_tid(); conv_all(cs, l == 0 ? CONV_P0_END : CONV_RS0_END, l == 0 ? CONV_RS0_END : CONV_TOTAL, sub * NWAVES + __builtin_amdgcn_readfirstlane(t2 >> 6), nhalf * NWAVES, (LAS unsigned*)(lds + (t2 >> 6) * 8448), t2 & 63); }
#endif
 SEAM(ph); }
            ++ph;
            if (RUN(ph)) {
#if EN_RO
 for (int rep = 0; rep < REP_RO; ++rep) ret_out_phase(lds, Z16, STATE, Yb, G, bid);
#endif
 SEAM(ph); }
            ++ph;
            mixA = Yb; mixB = (const f16*)(ws + WS_W_RETOUT) + (size_t)l * DM * 4096; mixK = 4096; HID = (f16*)(ws + WS_HID_RET);
        } else {
            const int j = l - 2;
            f16* KVb = (f16*)(ws + WS_KV); f16* QA = (f16*)(ws + WS_QATT); f16* OG = (f16*)(ws + WS_OG); f16* O16 = (f16*)(ws + WS_O16);
            if (RUN(ph)) {
                const int nkv = (j == 0) ? NKV : 0;
                pg8::Gemm gm{(const f16*)(ws + WS_XBA), (j == 0) ? (const f16*)(ws + WS_W_KV) : (const f16*)(ws + WS_W_Q) + (size_t)NATT * DM, M, nkv + NATT, DM}; pg8::StaticOrder S; S.init(M, nkv + NATT, G, bid);
                pg8::EpiPlain E{KVb, NKV, QA, NATT, nkv / 256, 0.08838834764831845f * 1.4426950408889634f, ss_mix};

#if EN_G2
 pg8::gemm_phase<pg8::EpiPlain, pg8::StaticOrder, true, true>(lds, gm, S, E);
#endif

                SEAM(ph);
            }
            ++ph;
#pragma clang loop unroll(disable)
            for (int part = 0; part < 2; ++part) {
                if (RUN(ph)) {
#if EN_AT
                    att_phase(part != 0, lds, KVb, QA, OG, LSE, biasT, G, bid, part ? 0 : 512, part ? 512 : 1024, O16);
#endif
                    SEAM(ph); }
                ++ph;
            }
            mixA = O16; mixB = (const f16*)(ws + WS_W_ATTOUT) + (size_t)j * DM * DM; mixK = DM; HID = (f16*)(ws + WS_HID_ATT);
        }
        if (RUN(ph)) {
            pg8::Gemm gm{mixA, mixB, M, DM, mixK}; pg8::StaticOrder S; S.init(M, DM, G, bid);
            pg8::EpiRes E{X16, ss_ffn, XB16};
#if EN_G3
            pg8::gemm_phase<pg8::EpiRes, pg8::StaticOrder, true, true>(lds, gm, S, E);
#endif

            SEAM(ph);
        }
        ++ph;
        if (RUN(ph)) {
            pg8::Gemm gm{XB16, (const f16*)(ws + WS_W_FFNIN) + (size_t)l * 2 * FF * DM, M, 2 * FF, DM}; pg8::StaticOrder S; S.init(M, 2 * FF, G, bid);
            pg8::EpiSwiglu E{HID, ss_ffn};

#if EN_G4
 pg8::gemm_phase<pg8::EpiSwiglu, pg8::StaticOrder, true, true>(lds, gm, S, E);
#endif

            SEAM(ph);
        }
        ++ph;
        if (RUN(ph)) {
            pg8::Gemm gm{HID, (const f16*)(ws + WS_W_FFNOUT) + (size_t)l * DM * FF, M, DM, FF}; pg8::StaticOrder S; S.init(M, DM, G, bid);
            pg8::EpiRes E{X16, ss_next, (l == 1 || l == 2) ? (f16*)(ws + WS_XBA) : nullptr};
#if EN_G5
            pg8::gemm_phase<pg8::EpiRes, pg8::StaticOrder, true, true>(lds, gm, S, E);
#endif

            SEAM(ph);
        }
        ++ph;
    }
    if (RUN(ph)) {
        const bool bad = (MK_N_LAUNCHES == 1) && (__hip_atomic_load(ctl + CW_BAR + XB_TMO, RLX_AGENT) != 0u);
        const int tid = opaque_tid(), lane = tid & 63, wave = __builtin_amdgcn_readfirstlane(tid >> 6);
        const float* ssf = ss + (size_t)8 * M; const int gw = vcu * NWAVES + wave, NGW = G * NWAVES;
        for (int m = gw; m < M; m += NGW) {
            const float rs = bad ? __builtin_nanf("") : __builtin_amdgcn_rsqf(ssf[m] * (1.0f / DM) + NORM_EPS);
            const u32x2* xr = (const u32x2*)(X16 + (size_t)m * DM) + lane; f32x4* orow = (f32x4*)(xres + (size_t)m * DM) + lane; const f32x4* gr = (const f32x4*)g_final + lane;
#pragma unroll
            for (int j = 0; j < 8; ++j) { const f16x4 hv = __builtin_bit_cast(f16x4, xr[64 * j]); orow[64 * j] = (f32x4){(float)hv[0], (float)hv[1], (float)hv[2], (float)hv[3]} * rs * gr[64 * j]; }
        }
    }
#undef RUN
#undef SEAM
}

extern "C" void kernel_launch(void* const* d_in, const int* in_sizes, int n_in, void* d_out, int out_size, void* d_ws, size_t ws_size, hipStream_t stream) {
    static int grid = 0;
    if (grid == 0) {
        if (n_in != 13 || in_sizes[0] != M * DM || out_size != M * DM || ws_size < WS_END) {
            fprintf(stderr, "kernel_launch: unexpected shapes (n_in %d, in0 %d, out %d, ws %zu < %zu); nothing launched\n", n_in, n_in > 0 ? in_sizes[0] : -1, out_size, ws_size, (size_t)WS_END); grid = -1; return; }
        int dev = 0, cus = 0, per_cu = 0;
        if (hipGetDevice(&dev) != hipSuccess || hipDeviceGetAttribute(&cus, hipDeviceAttributeMultiprocessorCount, dev) != hipSuccess) { grid = -1; return; }
        if (hipFuncSetAttribute((const void*)yoco_fwd, hipFuncAttributeMaxDynamicSharedMemorySize, LDS_BYTES) != hipSuccess) { fprintf(stderr, "kernel_launch: hipFuncSetAttribute failed\n"); grid = -1; return; }
        if (hipOccupancyMaxActiveBlocksPerMultiprocessor(&per_cu, (const void*)yoco_fwd, NWAVES * 64, LDS_BYTES) != hipSuccess || per_cu < 1)
            fprintf(stderr, "kernel_launch: note: occupancy query reports %d workgroups per CU\n", per_cu);
        (void)hipGetLastError();
        grid = cus;
    }
    if (grid < 0) return;
    if (hipMemsetAsync((char*)d_ws + WS_CTL, 0, CTL_ZERO_BYTES, stream) != hipSuccess) { fprintf(stderr, "kernel_launch: memset failed\n"); return; }
    Args a{};
    for (int i = 0; i < 13; ++i) a.in[i] = (const float*)d_in[i];
    a.out = (float*)d_out; a.ws = (unsigned char*)d_ws;
    if (MK_N_LAUNCHES == 1) {
        a.ph_lo = 0; a.ph_hi = N_PHASES;
        hipLaunchKernelGGL(yoco_fwd, dim3(grid), dim3(NWAVES * 64), LDS_BYTES, stream, a);
    } else {
        for (int k = 0; k < N_PHASES; ++k) { a.ph_lo = k; a.ph_hi = k + 1; hipLaunchKernelGGL(yoco_fwd, dim3(grid), dim3(NWAVES * 64), LDS_BYTES, stream, a); }
    }
    const hipError_t le = hipPeekAtLastError();
    if (le != hipSuccess) fprintf(stderr, "kernel_launch: launch failed: %s\n", hipGetErrorName(le));
}
```
